# Optimizing an MI355X kernel written in HIP

```python
import jax, jax.numpy as jnp
from jax import lax
import numpy as np

D_MODEL = 1024
BATCH = 8
SEQ = 2048
DEPTH = 4
DEC_BATCH = 128
DEC_SEQ = 4
PAST_LEN = 8192
PAGE_SIZE = 128

SWA_HEADS = 8
SWA_KV_HEADS = 2
SWA_HEAD_DIM = 64
SWA_GROUP = SWA_HEADS // SWA_KV_HEADS
WINDOW = 128
ROPE_THETA = 10000.0
HG_HEADS = 4
HG_DK = 128
HG_DV = 128
HG_CHUNK = 64
LB_FLOOR = 1e-30
POOL_WINDOWS = (2, 4, 8, 16)
POOL_GROUPS = 4
POOL_GROUP_DIM = 128
POOL_WIDTH = POOL_GROUPS * POOL_GROUP_DIM
POOL_BUF = 15
BRANCH_WIDTH = 512
N_BRANCH = 3
D_FF = 4 * D_MODEL
EPS = 1e-6
NEG = -1e30

SWA_Q = SWA_HEADS * SWA_HEAD_DIM
SWA_KV = SWA_KV_HEADS * SWA_HEAD_DIM
HG_K = HG_HEADS * HG_DK
HG_V = HG_HEADS * HG_DV
GATE_W = N_BRANCH * D_MODEL
P1 = SWA_Q
P2 = P1 + SWA_KV
P3 = P2 + SWA_KV
P4 = P3 + HG_K
P5 = P4 + HG_K
P6 = P5 + HG_V
P7 = P6 + HG_V
P8 = P7 + POOL_WIDTH
D_IN = P8 + GATE_W
SPLIT_POINTS = (P1, P2, P3, P4, P5, P6, P7, P8)

kernel_name = "hybrid_hgrn2_swa_pool_gated_decode_step"

F32 = jnp.float32


def rmsnorm(x, w):
    xf = x.astype(F32)
    y = xf * lax.rsqrt(jnp.mean(xf * xf, axis=-1, keepdims=True) + EPS) * w.astype(F32)
    return y.astype(x.dtype)


def rope(x, pos):
    hd = x.shape[-1]
    inv = jnp.power(ROPE_THETA, -jnp.arange(0, hd, 2, dtype=F32) / hd)
    ang = pos[:, None] * inv[None, :]
    cos = jnp.cos(ang)[:, None, :]
    sin = jnp.sin(ang)[:, None, :]
    xf = x.astype(F32)
    x1, x2 = xf[..., : hd // 2], xf[..., hd // 2:]
    return jnp.concatenate([x1 * cos - x2 * sin, x2 * cos + x1 * sin], axis=-1).astype(x.dtype)


def sink_softmax(s, mask, sink):
    sink = sink.astype(F32)
    sm = jnp.where(mask, s, NEG)
    m = jnp.maximum(jnp.max(sm, axis=-1, keepdims=True), sink)
    e = jnp.where(mask, jnp.exp(sm - m), 0.0)
    return e / (jnp.sum(e, axis=-1, keepdims=True) + jnp.exp(sink - m))


def swa_prompt(q, k, v, sinks):
    B, T = q.shape[:2]
    nb = T // WINDOW
    qb = q.astype(F32).reshape(B, nb, WINDOW, SWA_KV_HEADS, SWA_GROUP, SWA_HEAD_DIM)

    def with_prev(a):
        a = a.astype(F32).reshape(B, nb, WINDOW, SWA_KV_HEADS, SWA_HEAD_DIM)
        prev = jnp.pad(a, ((0, 0), (1, 0), (0, 0), (0, 0), (0, 0)))[:, :-1]
        return jnp.concatenate([prev, a], axis=2)

    kk = with_prev(k)
    vv = with_prev(v)
    s = jnp.einsum('bnqkgd,bnskd->bnkgqs', qb, kk) * (SWA_HEAD_DIM ** -0.5)
    i = jnp.arange(WINDOW)[:, None]
    j = jnp.arange(2 * WINDOW)[None, :]
    band = (j > i) & (j <= i + WINDOW)
    blk = jnp.arange(nb)[:, None, None]
    mask = band[None] & ((blk > 0) | (j[None] >= WINDOW))
    p = sink_softmax(s, mask[None, :, None, None], sinks.reshape(SWA_KV_HEADS, SWA_GROUP)[:, :, None, None])
    o = jnp.einsum('bnkgqs,bnskd->bnqkgd', p, vv)
    return o.reshape(B, T, SWA_Q).astype(q.dtype)


def swa_sample(q, k, v, k_buf, v_buf, sinks):
    B, T = q.shape[:2]
    WB = k_buf.shape[1]
    kk = jnp.concatenate([k_buf.astype(k.dtype), k], axis=1)
    vv = jnp.concatenate([v_buf.astype(v.dtype), v], axis=1)
    qpos = PAST_LEN + jnp.arange(T)[:, None]
    kpos = PAST_LEN - WB + jnp.arange(WB + T)[None, :]
    mask = (kpos <= qpos) & (qpos - kpos < WINDOW)
    qg = q.astype(F32).reshape(B, T, SWA_KV_HEADS, SWA_GROUP, SWA_HEAD_DIM)
    s = jnp.einsum('btkgd,bskd->bkgts', qg, kk.astype(F32)) * (SWA_HEAD_DIM ** -0.5)
    p = sink_softmax(s, mask, sinks.reshape(SWA_KV_HEADS, SWA_GROUP)[:, :, None, None])
    o = jnp.einsum('bkgts,bskd->btkgd', p, vv.astype(F32))
    return o.reshape(B, T, SWA_Q).astype(q.dtype), kk[:, -WB:], vv[:, -WB:]


def hgrn2(q, logf, kg, inp, S0):
    B, T = q.shape[:2]
    C = min(HG_CHUNK, T)
    pad = (-T) % C
    padw = ((0, 0), (0, pad), (0, 0), (0, 0))
    n = (T + pad) // C

    def chunks(a):
        a = jnp.pad(a, padw)
        return a.reshape(B, n, C, a.shape[2], a.shape[3]).swapaxes(0, 1)

    causal = jnp.tril(jnp.ones((C, C), dtype=bool))[None, :, :, None, None]

    def step(S, xs):
        qc, gc, kc, ic = xs
        G = jnp.cumsum(gc, axis=1)
        o_inter = jnp.einsum('bchd,bhde->bche', qc * jnp.exp(G), S)
        diff = G[:, :, None] - G[:, None, :]
        dec = jnp.where(causal, jnp.exp(jnp.where(causal, diff, 0.0)), 0.0)
        A = jnp.einsum('bthd,btshd,bshd->bhts', qc, dec, kc)
        o_intra = jnp.einsum('bhts,bshe->bthe', A, ic)
        G_last = G[:, -1]
        S_new = jnp.exp(G_last)[..., None] * S + jnp.einsum(
            'bshd,bshe->bhde', kc * jnp.exp(G_last[:, None] - G), ic)
        return S_new, o_inter + o_intra

    S, o = lax.scan(step, S0, (chunks(q), chunks(logf), chunks(kg), chunks(inp)))
    o = o.swapaxes(0, 1).reshape(B, n * C, HG_HEADS, HG_DV)[:, :T]
    return o, S


def pool_mix(u_ext, T, w_pool, scale):
    B, L, _ = u_ext.shape
    uf = u_ext.astype(F32)
    cs = jnp.concatenate([jnp.zeros((B, 1, POOL_WIDTH), F32), jnp.cumsum(uf, axis=1)], axis=1)
    e = jnp.arange(L - T, L)
    outs = []
    for g, w in enumerate(POOL_WINDOWS):
        sl = slice(g * POOL_GROUP_DIM, (g + 1) * POOL_GROUP_DIM)
        hi = cs[:, e + 1, sl]
        lo = cs[:, jnp.maximum(e + 1 - w, 0), sl]
        cnt = jnp.minimum(w, e + 1).astype(F32)[None, :, None]
        outs.append((hi - lo) / cnt - uf[:, e, sl])
    d = jnp.concatenate(outs, axis=-1).reshape(B, T, POOL_GROUPS, POOL_GROUP_DIM)
    y = jnp.einsum('btgc,gcd->btgd', d, w_pool.astype(F32)).reshape(B, T, POOL_WIDTH)
    return (y * scale.astype(F32)).astype(u_ext.dtype)


def decoder_layer(x, pos, lw, st):
    (norm_mix, w_in, q_norm, k_norm, sinks, lb, onorm, pool_w, pool_scale,
     w_branch, w_o, norm_ffn, w_up, w_down) = lw
    B, T, _ = x.shape
    xn = rmsnorm(x, norm_mix)
    z = xn @ w_in
    zq, zk, zv, hq, hf, hi, hg, u, zg = jnp.split(z, SPLIT_POINTS, axis=-1)

    q = rope(rmsnorm(zq.reshape(B, T, SWA_HEADS, SWA_HEAD_DIM), q_norm), pos)
    k = rope(rmsnorm(zk.reshape(B, T, SWA_KV_HEADS, SWA_HEAD_DIM), k_norm), pos)
    v = zv.reshape(B, T, SWA_KV_HEADS, SWA_HEAD_DIM)
    if st is None:
        WB = min(WINDOW, T)
        o_b = swa_prompt(q, k, v, sinks)
        k_new, v_new = k[:, -WB:], v[:, -WB:]
        S0 = jnp.zeros((B, HG_HEADS, HG_DK, HG_DV), F32)
        s_dtype = x.dtype
        u_ext = u
    else:
        S_in, k_buf, v_buf, p_buf = st
        o_b, k_new, v_new = swa_sample(q, k, v, k_buf, v_buf, sinks)
        S0 = S_in.astype(F32)
        s_dtype = S_in.dtype
        u_ext = jnp.concatenate([p_buf.astype(u.dtype), u], axis=1)

    zf = hf.astype(F32).reshape(B, T, HG_HEADS, HG_DK)
    lbh = lb.reshape(HG_HEADS, HG_DK)
    logf = jnp.logaddexp(jnp.log(jnp.maximum(lbh, LB_FLOOR)), jnp.log1p(-lbh) + jax.nn.log_sigmoid(zf))
    kg = (1.0 - lbh) * jax.nn.sigmoid(-zf)
    qh = jax.nn.silu(hq.astype(F32)).reshape(B, T, HG_HEADS, HG_DK)
    ih = hi.astype(F32).reshape(B, T, HG_HEADS, HG_DV)
    o, S_new = hgrn2(qh, logf, kg, ih, S0)
    o = rmsnorm(o, onorm) * jax.nn.silu(hg.astype(F32).reshape(B, T, HG_HEADS, HG_DV))
    o_a = o.reshape(B, T, HG_V).astype(x.dtype)

    o_c = pool_mix(u_ext, T, pool_w, pool_scale)
    p_new = u_ext[:, -POOL_BUF:]

    br = jnp.stack([o_a, o_b, o_c], axis=-2)
    proj = jnp.einsum('btnc,ncd->btnd', br, w_branch)
    gates = jax.nn.sigmoid(zg.reshape(B, T, N_BRANCH, D_MODEL))
    x = x + jnp.sum(gates * proj, axis=-2) @ w_o

    h = rmsnorm(x, norm_ffn) @ w_up
    x = x + jnp.square(jax.nn.relu(h)) @ w_down
    return x, (S_new.astype(s_dtype), k_new, v_new, p_new)


def setup_inputs(seed: int = 0) -> dict:
    key = jax.random.key(seed)
    ks = jax.random.split(key, 20)
    WB = min(WINDOW, PAST_LEN)

    def nrm(k, shape, s):
        return jax.random.normal(k, shape, F32) * s

    return {
        "x_prompt": nrm(ks[0], (BATCH, SEQ, D_MODEL), 1.0),
        "x_sample": nrm(ks[1], (DEC_BATCH, DEC_SEQ, D_MODEL), 1.0),
        "state_hgrn": nrm(ks[2], (DEPTH, DEC_BATCH, HG_HEADS, HG_DK, HG_DV), 0.5),
        "cache_swa_k": nrm(ks[3], (DEPTH, DEC_BATCH, WB, SWA_KV_HEADS, SWA_HEAD_DIM), 1.0),
        "cache_swa_v": nrm(ks[4], (DEPTH, DEC_BATCH, WB, SWA_KV_HEADS, SWA_HEAD_DIM), 1.0),
        "state_pool": nrm(ks[5], (DEPTH, DEC_BATCH, POOL_BUF, POOL_WIDTH), 1.0),
        "norm_mix": 1.0 + nrm(ks[6], (DEPTH, D_MODEL), 0.05),
        "w_in": nrm(ks[7], (DEPTH, D_MODEL, D_IN), D_MODEL ** -0.5),
        "q_norm": 1.0 + nrm(ks[8], (DEPTH, SWA_HEAD_DIM), 0.05),
        "k_norm": 1.0 + nrm(ks[9], (DEPTH, SWA_HEAD_DIM), 0.05),
        "attn_sinks": nrm(ks[10], (DEPTH, SWA_HEADS), 0.5),
        "hgrn_lb": nrm(ks[11], (DEPTH, HG_K), 0.1),
        "hgrn_onorm": 1.0 + nrm(ks[12], (DEPTH, HG_DV), 0.05),
        "pool_w": nrm(ks[13], (DEPTH, POOL_GROUPS, POOL_GROUP_DIM, POOL_GROUP_DIM), POOL_GROUP_DIM ** -0.5),
        "pool_scale": 1.0 + nrm(ks[14], (DEPTH, POOL_WIDTH), 0.1),
        "w_branch": nrm(ks[15], (DEPTH, N_BRANCH, BRANCH_WIDTH, D_MODEL), BRANCH_WIDTH ** -0.5),
        "w_o": nrm(ks[16], (DEPTH, D_MODEL, D_MODEL), D_MODEL ** -0.5),
        "norm_ffn": 1.0 + nrm(ks[17], (DEPTH, D_MODEL), 0.05),
        "w_up": nrm(ks[18], (DEPTH, D_MODEL, D_FF), D_MODEL ** -0.5),
        "w_down": nrm(ks[19], (DEPTH, D_FF, D_MODEL), D_FF ** -0.5),
    }


def reference(x_prompt, x_sample, state_hgrn, cache_swa_k, cache_swa_v, state_pool,
              norm_mix, w_in, q_norm, k_norm, attn_sinks, hgrn_lb, hgrn_onorm,
              pool_w, pool_scale, w_branch, w_o, norm_ffn, w_up, w_down):
    lbp = jax.nn.softmax(hgrn_lb.astype(F32), axis=0)
    lower = jnp.maximum(jnp.cumsum(lbp, axis=0) - lbp[0], 0.0)
    pos_p = jnp.arange(x_prompt.shape[1], dtype=F32)
    pos_s = jnp.arange(x_sample.shape[1], dtype=F32) + PAST_LEN
    hp, hs = x_prompt, x_sample
    sp = ([], [], [], [])
    ss = ([], [], [], [])
    for l in range(DEPTH):
        lw = (norm_mix[l], w_in[l], q_norm[l], k_norm[l], attn_sinks[l], lower[l], hgrn_onorm[l],
              pool_w[l], pool_scale[l], w_branch[l], w_o[l], norm_ffn[l], w_up[l], w_down[l])
        hp, new_p = decoder_layer(hp, pos_p, lw, None)
        hs, new_s = decoder_layer(hs, pos_s, lw, (state_hgrn[l], cache_swa_k[l], cache_swa_v[l], state_pool[l]))
        for lst, a in zip(sp, new_p):
            lst.append(a)
        for lst, a in zip(ss, new_s):
            lst.append(a)
    return (hp, hs,
            jnp.stack(sp[0]), jnp.stack(sp[1]), jnp.stack(sp[2]), jnp.stack(sp[3]),
            jnp.stack(ss[0]), jnp.stack(ss[1]), jnp.stack(ss[2]), jnp.stack(ss[3]))
```

```cpp
#include <hip/hip_runtime.h>
#include <hip/hip_cooperative_groups.h>
#include <cstdio>
#include <cstdint>
namespace cg = cooperative_groups;
#ifndef ONLY
#define ONLY -1
#endif
#define EN(k) (ONLY < 0 || ONLY == (k))
#ifndef REP_P0
#define REP_P0 1
#endif
#ifndef REP_A
#define REP_A 1
#endif
#ifndef REP_B
#define REP_B 1
#endif
#ifndef REP_C
#define REP_C 1
#endif
#ifndef REP_E
#define REP_E 1
#endif
#ifndef REP_HP
#define REP_HP 1
#endif
#ifndef REP_B1
#define REP_B1 1
#endif
#ifndef REP_B2
#define REP_B2 1
#endif
#ifndef REP_PP
#define REP_PP 1
#endif
#ifndef REP_SP
#define REP_SP 1
#endif
#ifndef REP_HS
#define REP_HS 1
#endif
#ifndef REP_D
#define REP_D 1
#endif
#ifndef REP_F
#define REP_F 1
#endif
#ifndef REP_P1
#define REP_P1 1
#endif
#ifndef REP_P3
#define REP_P3 1
#endif
#ifndef REP_TU
#define REP_TU 1
#endif
#ifndef REP_TF
#define REP_TF 1
#endif
#ifndef REP_SYNC
#define REP_SYNC 1
#endif
#ifndef MIXMASK
#define MIXMASK 63
#endif
#define EN2(k) ((ONLY < 0 || ONLY == 2 || ONLY == (k)) && ((MIXMASK >> ((k) - 20)) & 1))

namespace pg8 {
#define PG8_LAS __attribute__((address_space(3)))
typedef unsigned short bf16_t;
typedef short bf16x8 __attribute__((ext_vector_type(8)));
typedef float f32x4 __attribute__((ext_vector_type(4)));
typedef unsigned u32x4 __attribute__((ext_vector_type(4)));
constexpr int BM = 256, BK = 64, HALF = 128, HTB = HALF * BK * 2  , STAGE_BYTES = 8 * HTB, NXCD = 8, WGM = 8;

__host__ __device__ __forceinline__ int lds_byte(int r, int c) { const int st = (r >> 4) * 2 + (c >> 5), rr = r & 15, cc = c & 31, ob = rr * 64 + cc * 2; return st * 1024 + (ob ^ (((ob >> 9) & 1) << 5)); }
__host__ __device__ __forceinline__ void stage_rc(int b, int& R, int& C) { const int st = b / 1024, sb = b % 1024, swz = sb ^ (((sb >> 9) & 1) << 5); R = (st >> 1) * 16 + swz / 64; C = (st & 1) * 32 + (swz % 64) / 2; }
__host__ __device__ __forceinline__ int perm32(int rho) { const int n = rho >> 4, i = rho & 15; return 8 * (i >> 2) + 4 * n + (i & 3); }

struct Unit { int pm, pn; };
struct Gemm { const bf16_t* A; const bf16_t* Bt; int M, N, K; };

struct StaticOrder {
    int nM, nN, nwg, G, c;
    __host__ __device__ void init(int M, int N, int G_, int c_) { nM = M / BM; nN = N / BM; nwg = nM * nN; G = G_; c = c_; }
    __host__ __device__ bool next(int i, Unit& u) const {
        const long L = (long)i * G + c; if (L >= nwg) return false;
        int wgid = (int)L; { const int q = nwg / NXCD, r = nwg % NXCD, xcd = wgid % NXCD, off = wgid / NXCD; wgid = (xcd < r ? xcd * (q + 1) : r * (q + 1) + (xcd - r) * q) + off; }
        const int nig = WGM * nN, gid = wgid / nig, fm = gid * WGM, gsz = (nM - fm) < WGM ? (nM - fm) : WGM;
        u.pm = fm + ((wgid % nig) % gsz); u.pn = (wgid % nig) / gsz; return true;
    }
    __device__ __forceinline__ void a_ready(const Unit&) const {}
    __device__ __forceinline__ void done(const Unit&) const {}
};

__device__ __forceinline__ unsigned cvt_pk_bf16(float lo, float hi) { unsigned r; asm volatile("v_cvt_pk_bf16_f32 %0, %1, %2" : "=v"(r) : "v"(lo), "v"(hi)); return r; }
template <class Epi, class Sched, bool ALIGN_EPI = false, bool SP2 = false>
__device__ __forceinline__ void gemm_phase(PG8_LAS unsigned char* lds, const Gemm g, const Sched& S, const Epi& E) {
    int tid_o = threadIdx.x; asm volatile("" : "+v"(tid_o));
    const int tid = tid_o, wid = __builtin_amdgcn_readfirstlane(tid >> 6), lane = tid & 63, wr = wid >> 2, wc = wid & 3, fr = lane & 15, fq = lane >> 4;
    const int K = g.K, nt = K / BK;
    unsigned voffA[2], voffB[2];
#pragma unroll
    for (int i = 0; i < 2; ++i) { int R, C; stage_rc(tid * 16 + i * 8192, R, C); const int Rb = Epi::PERM ? ((R & ~31) + perm32(R & 31)) : R;
        voffA[i] = (unsigned)(R * K + C) * 2u; voffB[i] = (unsigned)(Rb * K + C) * 2u; }
    const size_t kstep = (size_t)(BK * 2);
    const size_t hstep = (size_t)HALF * K * 2;
    const size_t tstep = 2 * hstep;
    const unsigned ldsw = (unsigned)wid * 1024u;
    const int aoff = lds_byte(wr * 64 + fr, fq * 8), boff = lds_byte(wc * 32 + fr, fq * 8);
#define PG8_SA(b, h) (((b) * 2 + (h)) * HTB)
#define PG8_SB(b, h) ((4 + (b) * 2 + (h)) * HTB)
#define PG8_STAGE(bufoff, gbase, voff) do { _Pragma("unroll") for (int _i = 0; _i < 2; ++_i) \
        __builtin_amdgcn_global_load_lds((const unsigned*)((const char*)(gbase) + (voff)[_i]), (PG8_LAS unsigned*)(lds + (bufoff) + ldsw + _i * 8192), 16, 0, 0); } while (0)
#define PG8_LDA(dst, b, h) do { _Pragma("unroll") for (int m = 0; m < 4; ++m) _Pragma("unroll") for (int k = 0; k < 2; ++k) dst[m][k] = *(const PG8_LAS bf16x8*)(lds + PG8_SA(b, h) + aoff + m * 2048 + k * 1024); } while (0)
#define PG8_LDB(dst, b, h) do { _Pragma("unroll") for (int n = 0; n < 2; ++n) _Pragma("unroll") for (int k = 0; k < 2; ++k) dst[n][k] = *(const PG8_LAS bf16x8*)(lds + PG8_SB(b, h) + boff + n * 2048 + k * 1024); } while (0)
#define PG8_MMA(ai, bj, At, Bt) do { __builtin_amdgcn_s_setprio(1); _Pragma("unroll") for (int m = 0; m < 4; ++m) _Pragma("unroll") for (int n = 0; n < 2; ++n) _Pragma("unroll") for (int k = 0; k < 2; ++k) \
        acc[ai][bj][m][n] = __builtin_amdgcn_mfma_f32_16x16x32_bf16(Bt[n][k], At[m][k], acc[ai][bj][m][n], 0, 0, 0); __builtin_amdgcn_s_setprio(0); } while (0)
#define PG8_WAIT_V(n) asm volatile("s_waitcnt vmcnt(" #n ")" ::: "memory")
#define PG8_WAIT_L(n) asm volatile("s_waitcnt lgkmcnt(" #n ")" ::: "memory")
#define PG8_BAR __builtin_amdgcn_s_barrier()
#define PG8_SCHED __builtin_amdgcn_sched_barrier(0)
    Unit cur, nxt; int ui = 0;
    if (!S.next(0, cur)) return;
    f32x4 acc[2][2][4][2];
#pragma unroll
    for (int a = 0; a < 2; ++a)
#pragma unroll
        for (int b = 0; b < 2; ++b)
#pragma unroll
            for (int m = 0; m < 4; ++m)
#pragma unroll
                for (int n = 0; n < 2; ++n) acc[a][b][m][n] = (f32x4){0.f, 0.f, 0.f, 0.f};
    bf16x8 At[4][2], B0[2][2], B1[2][2];
    const char* cA = (const char*)g.A + (size_t)cur.pm * tstep; const char* cB = (const char*)g.Bt + (size_t)cur.pn * tstep;
    S.a_ready(cur);
    if constexpr (SP2) {
        PG8_STAGE(PG8_SB(0, 0), cB, voffB); PG8_STAGE(PG8_SB(0, 1), cB + hstep, voffB); PG8_STAGE(PG8_SA(0, 0), cA, voffA); PG8_STAGE(PG8_SA(0, 1), cA + hstep, voffA);
        if (wr == 1) PG8_BAR;
        PG8_WAIT_V(2); PG8_BAR;
        PG8_STAGE(PG8_SB(1, 0), cB + kstep, voffB); PG8_STAGE(PG8_SA(1, 0), cA + kstep, voffA); PG8_STAGE(PG8_SB(1, 1), cB + hstep + kstep, voffB);
        PG8_WAIT_V(6); PG8_BAR;
    } else {
        PG8_STAGE(PG8_SB(0, 0), cB, voffB); PG8_STAGE(PG8_SA(0, 0), cA, voffA); PG8_STAGE(PG8_SB(0, 1), cB + hstep, voffB); PG8_STAGE(PG8_SA(0, 1), cA + hstep, voffA);
        if (wr == 1) PG8_BAR;
        PG8_WAIT_V(4); PG8_BAR;
        PG8_STAGE(PG8_SB(1, 0), cB + kstep, voffB); PG8_STAGE(PG8_SA(1, 0), cA + kstep, voffA); PG8_STAGE(PG8_SB(1, 1), cB + hstep + kstep, voffB);
        PG8_WAIT_V(6); PG8_BAR;
    }
    for (;;) {
        const bool has_next = S.next(ui + 1, nxt);
        const char* nA = has_next ? (const char*)g.A + (size_t)nxt.pm * tstep : cA; const char* nB = has_next ? (const char*)g.Bt + (size_t)nxt.pn * tstep : cB;
        for (int t = 0; t < nt; t += 2) {
            const bool last = (t == nt - 2);
            const char* a1 = cA + (size_t)(t + 1) * kstep;
            const char* a2 = last ? nA : cA + (size_t)(t + 2) * kstep; const char* b2 = last ? nB : cB + (size_t)(t + 2) * kstep;
            const char* a3 = a2 + kstep; const char* b3 = b2 + kstep;
            if (last && has_next) S.a_ready(nxt);
            if constexpr (SP2) {
            PG8_LDB(B0, 0, 0); PG8_LDB(B1, 0, 1); PG8_SCHED; PG8_LDA(At, 0, 0); PG8_STAGE(PG8_SA(1, 1), a1 + hstep, voffA);
            PG8_WAIT_V(8); PG8_WAIT_L(0); PG8_BAR; PG8_MMA(0, 0, At, B0); PG8_MMA(0, 1, At, B1); PG8_BAR; PG8_SCHED;
            PG8_LDA(At, 0, 1); PG8_STAGE(PG8_SB(0, 0), b2, voffB); PG8_STAGE(PG8_SB(0, 1), b2 + hstep, voffB); PG8_STAGE(PG8_SA(0, 0), a2, voffA);
            PG8_WAIT_V(8); PG8_WAIT_L(0); PG8_BAR; PG8_MMA(1, 0, At, B0); PG8_MMA(1, 1, At, B1); PG8_BAR; PG8_SCHED;
            PG8_LDB(B0, 1, 0); PG8_LDB(B1, 1, 1); PG8_SCHED; PG8_LDA(At, 1, 0); PG8_STAGE(PG8_SA(0, 1), a2 + hstep, voffA);
            PG8_WAIT_V(8); PG8_WAIT_L(0); PG8_BAR; PG8_MMA(0, 0, At, B0); PG8_MMA(0, 1, At, B1); PG8_BAR; PG8_SCHED;
            PG8_LDA(At, 1, 1); PG8_STAGE(PG8_SB(1, 0), b3, voffB); PG8_STAGE(PG8_SB(1, 1), b3 + hstep, voffB); PG8_STAGE(PG8_SA(1, 0), a3, voffA);
            PG8_WAIT_V(8); PG8_WAIT_L(0); PG8_BAR; PG8_MMA(1, 0, At, B0); PG8_MMA(1, 1, At, B1); PG8_BAR; PG8_SCHED;
            } else {
            PG8_LDB(B0, 0, 0); PG8_SCHED; PG8_LDA(At, 0, 0); PG8_STAGE(PG8_SA(1, 1), a1 + hstep, voffA);
            PG8_WAIT_L(8); PG8_BAR; PG8_WAIT_L(0); PG8_MMA(0, 0, At, B0); PG8_BAR; PG8_SCHED;
            PG8_LDB(B1, 0, 1); PG8_STAGE(PG8_SB(0, 0), b2, voffB);
            PG8_BAR; PG8_WAIT_L(0); PG8_MMA(0, 1, At, B1); PG8_BAR;
            PG8_LDA(At, 0, 1); PG8_STAGE(PG8_SA(0, 0), a2, voffA);
            PG8_BAR; PG8_WAIT_L(0); PG8_MMA(1, 0, At, B0); PG8_BAR; PG8_SCHED;
            PG8_STAGE(PG8_SB(0, 1), b2 + hstep, voffB);
            PG8_WAIT_V(6); PG8_BAR; PG8_MMA(1, 1, At, B1); PG8_BAR;
            PG8_LDB(B0, 1, 0); PG8_SCHED; PG8_LDA(At, 1, 0); PG8_STAGE(PG8_SA(0, 1), a2 + hstep, voffA);
            PG8_WAIT_L(8); PG8_BAR; PG8_WAIT_L(0); PG8_MMA(0, 0, At, B0); PG8_BAR; PG8_SCHED;
            PG8_LDB(B1, 1, 1); PG8_STAGE(PG8_SB(1, 0), b3, voffB);
            PG8_BAR; PG8_WAIT_L(0); PG8_MMA(0, 1, At, B1); PG8_BAR;
            PG8_LDA(At, 1, 1); PG8_STAGE(PG8_SA(1, 0), a3, voffA);
            PG8_BAR; PG8_WAIT_L(0); PG8_MMA(1, 0, At, B0); PG8_BAR; PG8_SCHED;
            PG8_STAGE(PG8_SB(1, 1), b3 + hstep, voffB);
            PG8_WAIT_V(6); PG8_BAR; PG8_MMA(1, 1, At, B1); PG8_BAR;
            }
        }
        if constexpr (ALIGN_EPI) { if (wr == 0) PG8_BAR; }
        if constexpr (!Epi::AFTER_DRAIN) { E(acc, cur, wr, wc, fr, fq); S.done(cur); }
        if (!has_next) break;
#pragma unroll
        for (int a = 0; a < 2; ++a)
#pragma unroll
            for (int b = 0; b < 2; ++b)
#pragma unroll
                for (int m = 0; m < 4; ++m)
#pragma unroll
                    for (int n = 0; n < 2; ++n) acc[a][b][m][n] = (f32x4){0.f, 0.f, 0.f, 0.f};
        cur = nxt; cA = nA; cB = nB; ++ui;
        if constexpr (ALIGN_EPI) { if (wr == 1) PG8_BAR; }
    }
    PG8_WAIT_V(0);
    if constexpr (!ALIGN_EPI) { if (wr == 0) PG8_BAR; }
    PG8_BAR;
    if constexpr (Epi::AFTER_DRAIN) { E.fused(acc, cur, wr, wc, fr, fq, lds, wid, lane); S.done(cur); }
#undef PG8_SA
#undef PG8_SB
#undef PG8_STAGE
#undef PG8_LDA
#undef PG8_LDB
#undef PG8_MMA
#undef PG8_WAIT_V
#undef PG8_WAIT_L
#undef PG8_BAR
#undef PG8_SCHED
}
__device__ __forceinline__ float bf2f_(unsigned short h) { return __uint_as_float((unsigned)h << 16); }
__device__ __forceinline__ size_t gate_slot_off(int T, int i, int tid) { const unsigned q = (unsigned)((T * 16 + i) * 512 + tid); return (size_t)(q / 384u) * 6400 + 3328 + (size_t)(q % 384u) * 8; }
template <int ACT  , bool GATES = false> struct EpiScaleBf16 {
    static constexpr bool PERM = true, AFTER_DRAIN = false;
    bf16_t* O; int ldc; const float* rowss;
    __device__ __forceinline__ void operator()(const f32x4 (&acc)[2][2][4][2], const Unit& u, int wr, int wc, int fr, int fq) const {
        const int row0 = u.pm * BM + wr * 64 + fr, col0 = u.pn * BM + wc * 32 + 8 * fq;
        const bool gt = GATES && u.pn >= 13 && u.pm < 64; const int T = u.pm * 12 + (u.pn - 13), tid = (wr * 4 + wc) * 64 + fq * 16 + fr;
#pragma unroll
        for (int ai = 0; ai < 2; ++ai)
#pragma unroll
            for (int m = 0; m < 4; ++m) { const int row = row0 + ai * HALF + m * 16; const f32x4 r0 = *(const f32x4*)(rowss + (size_t)row * 16), r1 = *(const f32x4*)(rowss + (size_t)row * 16 + 4), r2 = *(const f32x4*)(rowss + (size_t)row * 16 + 8), r3 = *(const f32x4*)(rowss + (size_t)row * 16 + 12);
                const float rsum = (((r0[0] + r0[1]) + (r0[2] + r0[3])) + ((r1[0] + r1[1]) + (r1[2] + r1[3]))) + (((r2[0] + r2[1]) + (r2[2] + r2[3])) + ((r3[0] + r3[1]) + (r3[2] + r3[3])));
                const float rs = rsqrtf(rsum * (1.0f / 1024.0f) + 1e-6f);
                bf16_t* rowp = O + (size_t)row * ldc + col0;
#pragma unroll
                for (int bj = 0; bj < 2; ++bj) { f32x4 v0 = acc[ai][bj][m][0] * rs, v1 = acc[ai][bj][m][1] * rs;
                    if (ACT == 1) {
#pragma unroll
                        for (int j = 0; j < 4; ++j) { const float a = fmaxf(v0[j], 0.f), b = fmaxf(v1[j], 0.f); v0[j] = a * a; v1[j] = b * b; } }
                    u32x4 w; w.x = cvt_pk_bf16(v0[0], v0[1]); w.y = cvt_pk_bf16(v0[2], v0[3]); w.z = cvt_pk_bf16(v1[0], v1[1]); w.w = cvt_pk_bf16(v1[2], v1[3]);
                    if (gt) *(u32x4*)(O + gate_slot_off(T, (ai * 4 + m) * 2 + bj, tid)) = w;
                    else *(u32x4*)(rowp + bj * HALF) = w; } }
    }
};
struct EpiBranch {
    static constexpr bool PERM = true, AFTER_DRAIN = false;
    const bf16_t* Z; bf16_t* gb; int nmt;
    __device__ __forceinline__ void operator()(const f32x4 (&acc)[2][2][4][2], const Unit& u, int wr, int wc, int fr, int fq) const {
        const int br = u.pm / nmt, pm = u.pm - br * nmt, pn = u.pn - br * 4;
        const int row0 = pm * BM + wr * 64 + fr, col0 = pn * BM + wc * 32 + 8 * fq;
        bf16_t* gp0 = gb + (size_t)row0 * 1024 + col0; const int T = pm * 12 + br * 4 + pn, tid = (wr * 4 + wc) * 64 + fq * 16 + fr;
#pragma unroll
        for (int ai = 0; ai < 2; ++ai)
#pragma unroll
            for (int mh = 0; mh < 4; ++mh) {
                u32x4 gz[2], pz[2];
#pragma unroll
                for (int i = 0; i < 2; ++i) { const int m = mh, bj = i; const size_t ro = (size_t)(ai * HALF + m * 16);
                    gz[i] = *(const u32x4*)(Z + gate_slot_off(T, (ai * 4 + m) * 2 + bj, tid));
                    if (br != 0) pz[i] = *(const u32x4*)(gp0 + ro * 1024 + bj * HALF); }
                asm volatile("" ::: "memory");
#pragma unroll
                for (int i = 0; i < 2; ++i) { const int m = mh, bj = i; const size_t ro = (size_t)(ai * HALF + m * 16);
                    f32x4 g0, g1;
                    g0[0] = __uint_as_float(gz[i].x << 16); g0[1] = __uint_as_float(gz[i].x & 0xffff0000u); g0[2] = __uint_as_float(gz[i].y << 16); g0[3] = __uint_as_float(gz[i].y & 0xffff0000u);
                    g1[0] = __uint_as_float(gz[i].z << 16); g1[1] = __uint_as_float(gz[i].z & 0xffff0000u); g1[2] = __uint_as_float(gz[i].w << 16); g1[3] = __uint_as_float(gz[i].w & 0xffff0000u);
#pragma unroll
                    for (int j = 0; j < 4; ++j) { g0[j] = __builtin_amdgcn_rcpf(1.f + __builtin_amdgcn_exp2f(g0[j] * -1.4426950408889634f)); g1[j] = __builtin_amdgcn_rcpf(1.f + __builtin_amdgcn_exp2f(g1[j] * -1.4426950408889634f)); }
                    f32x4 v0 = acc[ai][bj][m][0] * g0, v1 = acc[ai][bj][m][1] * g1;
                    if (br != 0) {
                        v0[0] += __uint_as_float(pz[i].x << 16); v0[1] += __uint_as_float(pz[i].x & 0xffff0000u); v0[2] += __uint_as_float(pz[i].y << 16); v0[3] += __uint_as_float(pz[i].y & 0xffff0000u);
                        v1[0] += __uint_as_float(pz[i].z << 16); v1[1] += __uint_as_float(pz[i].z & 0xffff0000u); v1[2] += __uint_as_float(pz[i].w << 16); v1[3] += __uint_as_float(pz[i].w & 0xffff0000u); }
                    u32x4 w; w.x = cvt_pk_bf16(v0[0], v0[1]); w.y = cvt_pk_bf16(v0[2], v0[3]); w.z = cvt_pk_bf16(v1[0], v1[1]); w.w = cvt_pk_bf16(v1[2], v1[3]);
                    *(u32x4*)(gp0 + ro * 1024 + bj * HALF) = w; }
            }
    }
};
struct EpiResid {
    static constexpr bool PERM = true, AFTER_DRAIN = false;
    const bf16_t* res; bf16_t* xo; float* Xf; float* rowss;
    __device__ __forceinline__ void operator()(const f32x4 (&acc)[2][2][4][2], const Unit& u, int wr, int wc, int fr, int fq) const {
        const int row0 = u.pm * BM + wr * 64 + fr, col0 = u.pn * BM + wc * 32 + 8 * fq;
#pragma unroll
        for (int ai = 0; ai < 2; ++ai)
#pragma unroll
            for (int m = 0; m < 4; ++m) { const int row = row0 + ai * HALF + m * 16; float ss = 0.f;
#pragma unroll
                for (int bj = 0; bj < 2; ++bj) { const int c = col0 + bj * HALF;
                    const u32x4 rz = *(const u32x4*)(res + (size_t)row * 1024 + c);
                    f32x4 v0 = acc[ai][bj][m][0], v1 = acc[ai][bj][m][1];
                    v0[0] += __uint_as_float(rz.x << 16); v0[1] += __uint_as_float(rz.x & 0xffff0000u); v0[2] += __uint_as_float(rz.y << 16); v0[3] += __uint_as_float(rz.y & 0xffff0000u);
                    v1[0] += __uint_as_float(rz.z << 16); v1[1] += __uint_as_float(rz.z & 0xffff0000u); v1[2] += __uint_as_float(rz.w << 16); v1[3] += __uint_as_float(rz.w & 0xffff0000u);
                    if (Xf) { float* xp = Xf + (size_t)row * 1024 + c; *(f32x4*)xp = v0; *(f32x4*)(xp + 4) = v1; }
                    u32x4 w; w.x = cvt_pk_bf16(v0[0], v0[1]); w.y = cvt_pk_bf16(v0[2], v0[3]); w.z = cvt_pk_bf16(v1[0], v1[1]); w.w = cvt_pk_bf16(v1[2], v1[3]);
                    *(u32x4*)(xo + (size_t)row * 1024 + c) = w;
                    ss += (v0[0] * v0[0] + v0[1] * v0[1]) + (v0[2] * v0[2] + v0[3] * v0[3]) + (v1[0] * v1[0] + v1[1] * v1[1]) + (v1[2] * v1[2] + v1[3] * v1[3]); }
                ss += __shfl_xor(ss, 16); ss += __shfl_xor(ss, 32);
                if (fq == 0) rowss[(size_t)row * 16 + u.pn * 4 + wc] = ss; }
    }
};
struct BranchOrder {
    StaticOrder base; int nmt;
    __device__ void init(int Mtiles_rows, int Mpitch_rows, int G_, int c_) { base.init(Mtiles_rows, 1024, G_, c_); nmt = Mpitch_rows / BM; }
    __device__ bool next(int i, Unit& u) const { const int ti = i / 3, br = i - 3 * ti; Unit t; if (!base.next(ti, t)) return false; u.pm = br * nmt + t.pm; u.pn = br * 4 + t.pn; return true; }
    __device__ __forceinline__ void a_ready(const Unit&) const {}
    __device__ __forceinline__ void done(const Unit&) const {}
};
}

#define LAS __attribute__((address_space(3)))
typedef unsigned short bf16;
typedef short bf16x8 __attribute__((ext_vector_type(8)));
typedef float f32x4 __attribute__((ext_vector_type(4)));
typedef unsigned u32x4 __attribute__((ext_vector_type(4)));
typedef unsigned u32x2 __attribute__((ext_vector_type(2)));

constexpr int DMODEL = 1024, NB = 8, SEQ = 2048, DEPTH = 4, DECB = 128, DECT = 4, PAST = 8192;
constexpr int MP = NB * SEQ, MS = DECB * DECT, MT = MP + MS;
constexpr int DIN = 6400, DFF = 4096, NMT = MT / 256;
constexpr int C_ZQ = 0, C_ZK = 512, C_ZV = 640, C_HQ = 768, C_HF = 1280, C_HI = 1792, C_HG = 2304, C_U = 2816, C_ZG = 3328;
constexpr float LOG2E = 1.4426950408889634f;
constexpr size_t O_Y = 0, O_SHP = (size_t)MT * 1024, O_CKP = O_SHP + (size_t)4 * 8 * 4 * 128 * 128, O_CVP = O_CKP + (size_t)4 * 8 * 128 * 128,
                 O_SPP = O_CVP + (size_t)4 * 8 * 128 * 128, O_SHS = O_SPP + (size_t)4 * 8 * 15 * 512, O_CKS = O_SHS + (size_t)4 * 128 * 4 * 128 * 128,
                 O_CVS = O_CKS + (size_t)4 * 128 * 128 * 128, O_SPS = O_CVS + (size_t)4 * 128 * 128 * 128;
constexpr size_t WS_CTL = 0, CTL_BYTES = 1u << 20;
constexpr size_t WS_WIN = WS_CTL + CTL_BYTES;
constexpr size_t WS_WBR = WS_WIN + (size_t)4 * 6400 * 1024 * 2;
constexpr size_t WS_WO = WS_WBR + (size_t)4 * 3 * 1024 * 512 * 2;
constexpr size_t WS_WUP = WS_WO + (size_t)4 * 1024 * 1024 * 2;
constexpr size_t WS_WDN = WS_WUP + (size_t)4 * 4096 * 1024 * 2;
constexpr size_t WS_WPL = WS_WDN + (size_t)4 * 4096 * 1024 * 2;
constexpr size_t WS_Z = WS_WPL + (size_t)4 * 4 * 128 * 128 * 2;
constexpr size_t WS_XB = WS_Z + (size_t)MT * 6400 * 2;
constexpr size_t WS_BR = WS_XB + (size_t)MT * 1024 * 2;
constexpr size_t WS_G = WS_BR + (size_t)3 * MT * 512 * 2;
constexpr size_t WS_SST_OFF = (size_t)1024 * 16384 * 2;
constexpr size_t WS_RS = WS_G + (size_t)MT * 1024 * 4;
constexpr size_t WS_OI = WS_RS + (size_t)9 * MT * 16 * 4;
constexpr size_t WS_DV = WS_OI + (size_t)1024 * 8192 * 2;
constexpr size_t WS_END = WS_DV + (size_t)1024 * 128 * 4;

struct KP { const float* in[20]; float* out; unsigned char* ws; int ph_lo, ph_hi; };
typedef const __attribute__((address_space(4))) KP* KPp;
__device__ __forceinline__ KPp kargs() { KPp q = (KPp)__builtin_amdgcn_kernarg_segment_ptr(); asm volatile("" : "+s"(q)); return q; }

__device__ __forceinline__ float bf2f(unsigned short h) { return __uint_as_float((unsigned)h << 16); }
__device__ __forceinline__ unsigned pk2(float lo, float hi) { return pg8::cvt_pk_bf16(lo, hi); }
__device__ __forceinline__ unsigned short f2bf(float f) { return (unsigned short)(pk2(f, 0.f) & 0xffffu); }
__device__ __forceinline__ int opq_tid() { int t = threadIdx.x; asm volatile("" : "+v"(t)); return t; }
__device__ __forceinline__ float sigm(float x) { return __builtin_amdgcn_rcpf(1.f + __expf(-x)); }
__device__ __forceinline__ f32x4 mfma16(bf16x8 a, bf16x8 b, f32x4 c) { return __builtin_amdgcn_mfma_f32_16x16x32_bf16(a, b, c, 0, 0, 0); }
__device__ __forceinline__ bf16x8 pack8(const float (&y)[8]) { u32x4 w; w.x = pk2(y[0], y[1]); w.y = pk2(y[2], y[3]); w.z = pk2(y[4], y[5]); w.w = pk2(y[6], y[7]); return __builtin_bit_cast(bf16x8, w); }
#define LDS_WAIT() asm volatile("s_waitcnt lgkmcnt(0)" ::: "memory")
#define LBAR() asm volatile("s_waitcnt lgkmcnt(0)\n\ts_barrier" ::: "memory")

__device__ __forceinline__ void p0_transpose_item(const float* W, int K, int N, bf16* WT, const float* ksc, LAS bf16* T, int item, int lane) {
    const int nblk = N / 64, kb = item / nblk, nb = item - kb * nblk, k0 = 64 * kb, n0 = 64 * nb, r4 = lane >> 4, c4 = lane & 15;
    f32x4 v[16];
#pragma unroll
    for (int i = 0; i < 16; ++i) v[i] = *(const f32x4*)(W + (size_t)(k0 + 4 * i + r4) * N + n0 + 4 * c4);
    if (ksc) {
#pragma unroll
        for (int i = 0; i < 16; ++i) v[i] = v[i] * ksc[k0 + 4 * i + r4]; }
#pragma unroll
    for (int i = 0; i < 16; ++i) { const unsigned w0 = pk2(v[i][0], v[i][1]), w1 = pk2(v[i][2], v[i][3]); const int kk = 4 * i + r4;
        T[(4 * c4 + 0) * 72 + kk] = (bf16)(w0 & 0xffffu); T[(4 * c4 + 1) * 72 + kk] = (bf16)(w0 >> 16); T[(4 * c4 + 2) * 72 + kk] = (bf16)(w1 & 0xffffu); T[(4 * c4 + 3) * 72 + kk] = (bf16)(w1 >> 16); }
    LDS_WAIT(); asm volatile("" ::: "memory");
#pragma unroll
    for (int j = 0; j < 8; ++j) { const int n = (lane >> 3) + 8 * j, c = lane & 7;
        *(u32x4*)(WT + (size_t)(n0 + n) * K + k0 + 8 * c) = *(const LAS u32x4*)(T + n * 72 + 8 * c); }
    LDS_WAIT(); asm volatile("" ::: "memory");
}
__device__ __forceinline__ void wconv_layer(KPp p, int l, LAS unsigned char* lds, int blk0, int part) {
    const int tid = opq_tid(), lane = tid & 63, wave = tid >> 6;
    LAS bf16* scr = (LAS bf16*)(lds + wave * 16384);
    const int gw = ((int)blockIdx.x - blk0) * 8 + wave, NGW = ((int)gridDim.x - blk0) * 8;
    constexpr int I_IN = 16 * 100, I_BR = 8 * 16, I_O = 16 * 16, I_UP = 16 * 64, I_DN = 64 * 16, I_PL = 2 * 2;
    constexpr int P0N = I_IN + 4 * I_PL, PER_L = P0N + 3 * I_BR + I_O + I_UP + I_DN;
    unsigned char* ws = p->ws;
    const int r_lo = part == 0 ? 0 : P0N, r_hi = part == 0 ? P0N : PER_L;
#pragma unroll 1
    for (int it = r_lo + gw; it < r_hi; it += NGW) {
        int r = it;
        if (r < I_IN) { p0_transpose_item(p->in[7] + (size_t)l * 1024 * 6400, 1024, 6400, (bf16*)(ws + WS_WIN) + (size_t)l * 6400 * 1024, p->in[6] + l * 1024, scr, r, lane); continue; } r -= I_IN;
        if (r < 4 * I_PL) { const int g = r / I_PL; r -= g * I_PL; p0_transpose_item(p->in[13] + (size_t)(l * 4 + g) * 128 * 128, 128, 128, (bf16*)(ws + WS_WPL) + (size_t)(l * 4 + g) * 128 * 128, nullptr, scr, r, lane); continue; } r -= 4 * I_PL;
        if (r < 3 * I_BR) { const int n = r / I_BR; r -= n * I_BR; p0_transpose_item(p->in[15] + (size_t)(l * 3 + n) * 512 * 1024, 512, 1024, (bf16*)(ws + WS_WBR) + (size_t)(l * 3 + n) * 1024 * 512, nullptr, scr, r, lane); continue; } r -= 3 * I_BR;
        if (r < I_O) { p0_transpose_item(p->in[16] + (size_t)l * 1024 * 1024, 1024, 1024, (bf16*)(ws + WS_WO) + (size_t)l * 1024 * 1024, nullptr, scr, r, lane); continue; } r -= I_O;
        if (r < I_UP) { p0_transpose_item(p->in[18] + (size_t)l * 1024 * 4096, 1024, 4096, (bf16*)(ws + WS_WUP) + (size_t)l * 4096 * 1024, p->in[17] + l * 1024, scr, r, lane); continue; } r -= I_UP;
        p0_transpose_item(p->in[19] + (size_t)l * 4096 * 1024, 4096, 1024, (bf16*)(ws + WS_WDN) + (size_t)l * 1024 * 4096, nullptr, scr, r, lane);
    }
}
__device__ __forceinline__ void prologue(KPp p, LAS unsigned char* lds) {
    wconv_layer(p, 0, lds, 0, 0);
    const int lane = threadIdx.x & 63, wave = threadIdx.x >> 6;
    const int gw = blockIdx.x * 8 + wave, NGW = gridDim.x * 8;
    unsigned char* ws = p->ws;
    bf16* xb = (bf16*)(ws + WS_XB); float* rowss = (float*)(ws + WS_RS);
    for (int m = gw; m < MT; m += NGW) {
        const float* src = (m < MP) ? p->in[0] + (size_t)m * 1024 : p->in[1] + (size_t)(m - MP) * 1024;
        float ss = 0.f;
#pragma unroll
        for (int j = 0; j < 4; ++j) { const f32x4 v = *((const f32x4*)src + lane + 64 * j);
            u32x2 w; w.x = pk2(v[0], v[1]); w.y = pk2(v[2], v[3]); *((u32x2*)(xb + (size_t)m * 1024) + lane + 64 * j) = w;
            ss += (v[0] * v[0] + v[1] * v[1]) + (v[2] * v[2] + v[3] * v[3]); }
#pragma unroll
        for (int o = 1; o < 64; o <<= 1) ss += __shfl_xor(ss, o);
        if (lane < 16) rowss[(size_t)m * 16 + lane] = (lane == 0) ? ss : 0.f;
    }
}

__device__ __forceinline__ void rope_cs(float pos, int i, float& c, float& s) {
    const float invr = __builtin_amdgcn_exp2f(-(float)i * 0.41524101186092029f) * 0.15915494309189535f;
    const float pr = pos * invr, er = fmaf(pos, invr, -pr), r = (pr - rintf(pr)) + er;
    s = __builtin_amdgcn_sinf(r); c = __builtin_amdgcn_cosf(r);
}
__device__ __forceinline__ void rope_tab8(float pos, int sq, float (&c)[8], float (&s)[8]) {
#pragma unroll
    for (int e = 0; e < 8; ++e) rope_cs(pos, 8 * sq + e, c[e], s[e]);
}
__device__ __forceinline__ void norm_rope8t(float (&y1)[8], float (&y2)[8], float ss, const float* w, int sq, const float (&c)[8], const float (&s)[8], float oscale) {
    const float rs = rsqrtf(ss * (1.f / 64.f) + 1e-6f);
#pragma unroll
    for (int e = 0; e < 8; ++e) { const float a = y1[e] * rs * w[8 * sq + e], b = y2[e] * rs * w[32 + 8 * sq + e];
        y1[e] = (a * c[e] - b * s[e]) * oscale; y2[e] = (b * c[e] + a * s[e]) * oscale; }
}
__device__ __forceinline__ void norm_rope8(float (&y1)[8], float (&y2)[8], float ss, const float* w, int sq, float pos, float oscale) {
    float c[8], s[8]; rope_tab8(pos, sq, c, s); norm_rope8t(y1, y2, ss, w, sq, c, s, oscale);
}
__device__ __forceinline__ float unpack8(const bf16x8 v, float (&y)[8]) { float ss = 0.f;
#pragma unroll
    for (int e = 0; e < 8; ++e) { y[e] = bf2f((unsigned short)v[e]); ss += y[e] * y[e]; } return ss; }

template <int NKT, int VP, bool UNI>
__device__ __forceinline__ void attn_core(const LAS bf16* Ks, const LAS bf16* Vt, int kt0, bf16x8 q0, bf16x8 q1, int lo, int hi, int minkey, float sink2, f32x4 (&o)[4], float& inv_denom) {
    const int lane = opq_tid() & 63, l16 = lane & 15, q4 = lane >> 4;
    f32x4 acc[NKT];
    { bf16x8 kf[NKT][2];
#pragma unroll
        for (int mt = 0; mt < NKT; ++mt) { const LAS bf16* kp = Ks + (16 * (kt0 + mt) + l16) * 72 + 8 * q4; kf[mt][0] = *(const LAS bf16x8*)kp; kf[mt][1] = *(const LAS bf16x8*)(kp + 32); }
        asm volatile("" ::: "memory");
#pragma unroll
        for (int mt = 0; mt < NKT; ++mt) { acc[mt] = mfma16(kf[mt][0], q0, (f32x4){0.f, 0.f, 0.f, 0.f}); acc[mt] = mfma16(kf[mt][1], q1, acc[mt]); } }
    float mx = sink2;
    const int lo_max = lo + (15 - l16), lo_min = lo - l16;
    const int hi_min = hi - l16;
#pragma unroll
    for (int mt = 0; mt < NKT; ++mt) { const int k0 = 16 * (kt0 + mt);
        const bool whole_l = (k0 > lo_max) && (k0 + 15 <= hi_min) && (k0 >= minkey);
        const bool whole = UNI ? (__builtin_amdgcn_readfirstlane((int)whole_l) != 0) : whole_l;
        if (whole) {
#pragma unroll
            for (int j = 0; j < 4; ++j) mx = fmaxf(mx, acc[mt][j]);
        } else {
#pragma unroll
            for (int j = 0; j < 4; ++j) { const int jj = k0 + 4 * q4 + j; const bool v = (jj > lo) && (jj <= hi) && (jj >= minkey); const float sv = v ? acc[mt][j] : -1e30f; acc[mt][j] = sv; mx = fmaxf(mx, sv); } } }
    mx = fmaxf(mx, __shfl_xor(mx, 16)); mx = fmaxf(mx, __shfl_xor(mx, 32));
    float sum = 0.f;
#pragma unroll
    for (int mt = 0; mt < NKT; ++mt)
#pragma unroll
        for (int j = 0; j < 4; ++j) { const float e = __builtin_amdgcn_exp2f(fmaxf(acc[mt][j] - mx, -126.f)); acc[mt][j] = e; sum += e; }
    sum += __shfl_xor(sum, 16); sum += __shfl_xor(sum, 32);
    inv_denom = 1.f / (sum + __builtin_amdgcn_exp2f(fmaxf(sink2 - mx, -126.f)));
#pragma unroll
    for (int dt = 0; dt < 4; ++dt) o[dt] = (f32x4){0.f, 0.f, 0.f, 0.f};
#pragma unroll
    for (int pp = 0; pp < NKT / 2; ++pp) {
        u32x4 pw; pw.x = pk2(acc[2 * pp][0], acc[2 * pp][1]); pw.y = pk2(acc[2 * pp][2], acc[2 * pp][3]); pw.z = pk2(acc[2 * pp + 1][0], acc[2 * pp + 1][1]); pw.w = pk2(acc[2 * pp + 1][2], acc[2 * pp + 1][3]);
        const bf16x8 pb = __builtin_bit_cast(bf16x8, pw);
        u32x4 aw[4];
#pragma unroll
        for (int dt = 0; dt < 4; ++dt) { const LAS bf16* vp = Vt + (16 * dt + l16) * VP + 16 * kt0 + 32 * pp + 4 * q4;
            const u32x2 a0 = *(const LAS u32x2*)vp, a1 = *(const LAS u32x2*)(vp + 16);
            aw[dt].x = a0.x; aw[dt].y = a0.y; aw[dt].z = a1.x; aw[dt].w = a1.y; }
        asm volatile("" ::: "memory");
#pragma unroll
        for (int dt = 0; dt < 4; ++dt) o[dt] = mfma16(__builtin_bit_cast(bf16x8, aw[dt]), pb, o[dt]);
    }
}

template <int NKT, int VP>
__device__ __forceinline__ void attn_core2(const LAS bf16* Ks, const LAS bf16* Vt, int kt0, const bf16x8 (&qf)[2][2], int lo, int hi, int minkey, const float (&sink2)[2], f32x4 (&o)[2][4], float (&inv_denom)[2]) {
    const int lane = opq_tid() & 63, l16 = lane & 15, q4 = lane >> 4;
    f32x4 acc[2][NKT];
    { bf16x8 kf[NKT][2];
#pragma unroll
        for (int mt = 0; mt < NKT; ++mt) { const LAS bf16* kp = Ks + (16 * (kt0 + mt) + l16) * 72 + 8 * q4; kf[mt][0] = *(const LAS bf16x8*)kp; kf[mt][1] = *(const LAS bf16x8*)(kp + 32); }
        asm volatile("" ::: "memory");
#pragma unroll
        for (int mt = 0; mt < NKT; ++mt)
#pragma unroll
            for (int hh = 0; hh < 2; ++hh) { acc[hh][mt] = mfma16(kf[mt][0], qf[hh][0], (f32x4){0.f, 0.f, 0.f, 0.f}); acc[hh][mt] = mfma16(kf[mt][1], qf[hh][1], acc[hh][mt]); } }
    float mx[2] = {sink2[0], sink2[1]};
    const int lo_max = lo + (15 - l16), hi_min = hi - l16;
#pragma unroll
    for (int mt = 0; mt < NKT; ++mt) { const int k0 = 16 * (kt0 + mt);
        const bool whole = __builtin_amdgcn_readfirstlane((int)((k0 > lo_max) && (k0 + 15 <= hi_min) && (k0 >= minkey))) != 0;
        if (whole) {
#pragma unroll
            for (int j = 0; j < 4; ++j) { mx[0] = fmaxf(mx[0], acc[0][mt][j]); mx[1] = fmaxf(mx[1], acc[1][mt][j]); }
        } else {
#pragma unroll
            for (int j = 0; j < 4; ++j) { const int jj = k0 + 4 * q4 + j; const bool v = (jj > lo) && (jj <= hi) && (jj >= minkey);
                const float s0 = v ? acc[0][mt][j] : -1e30f, s1 = v ? acc[1][mt][j] : -1e30f; acc[0][mt][j] = s0; acc[1][mt][j] = s1; mx[0] = fmaxf(mx[0], s0); mx[1] = fmaxf(mx[1], s1); } } }
#pragma unroll
    for (int hh = 0; hh < 2; ++hh) { mx[hh] = fmaxf(mx[hh], __shfl_xor(mx[hh], 16)); mx[hh] = fmaxf(mx[hh], __shfl_xor(mx[hh], 32)); }
    float sum[2] = {0.f, 0.f};
#pragma unroll
    for (int hh = 0; hh < 2; ++hh)
#pragma unroll
        for (int mt = 0; mt < NKT; ++mt)
#pragma unroll
            for (int j = 0; j < 4; ++j) { const float e = __builtin_amdgcn_exp2f(fmaxf(acc[hh][mt][j] - mx[hh], -126.f)); acc[hh][mt][j] = e; sum[hh] += e; }
#pragma unroll
    for (int hh = 0; hh < 2; ++hh) { sum[hh] += __shfl_xor(sum[hh], 16); sum[hh] += __shfl_xor(sum[hh], 32); inv_denom[hh] = 1.f / (sum[hh] + __builtin_amdgcn_exp2f(fmaxf(sink2[hh] - mx[hh], -126.f)));
#pragma unroll
        for (int dt = 0; dt < 4; ++dt) o[hh][dt] = (f32x4){0.f, 0.f, 0.f, 0.f}; }
#pragma unroll
    for (int pp = 0; pp < NKT / 2; ++pp) {
        bf16x8 pb[2];
#pragma unroll
        for (int hh = 0; hh < 2; ++hh) { u32x4 pw; pw.x = pk2(acc[hh][2 * pp][0], acc[hh][2 * pp][1]); pw.y = pk2(acc[hh][2 * pp][2], acc[hh][2 * pp][3]); pw.z = pk2(acc[hh][2 * pp + 1][0], acc[hh][2 * pp + 1][1]); pw.w = pk2(acc[hh][2 * pp + 1][2], acc[hh][2 * pp + 1][3]); pb[hh] = __builtin_bit_cast(bf16x8, pw); }
        u32x4 aw[4];
#pragma unroll
        for (int dt = 0; dt < 4; ++dt) { const LAS bf16* vp = Vt + (16 * dt + l16) * VP + 16 * kt0 + 32 * pp + 4 * q4;
            const u32x2 a0 = *(const LAS u32x2*)vp, a1 = *(const LAS u32x2*)(vp + 16);
            aw[dt].x = a0.x; aw[dt].y = a0.y; aw[dt].z = a1.x; aw[dt].w = a1.y; }
        asm volatile("" ::: "memory");
#pragma unroll
        for (int dt = 0; dt < 4; ++dt) { o[0][dt] = mfma16(__builtin_bit_cast(bf16x8, aw[dt]), pb[0], o[0][dt]); o[1][dt] = mfma16(__builtin_bit_cast(bf16x8, aw[dt]), pb[1], o[1][dt]); }
    }
}

__device__ __forceinline__ void swa_prompt_item(KPp p, int l, int item, LAS unsigned char* lds) {
    const int tid = opq_tid(), lane = tid & 63, wave = tid >> 6, l16 = lane & 15, q4 = lane >> 4;
    const int qb = item & 15, kvh = (item >> 4) & 1, b = item >> 5;
    LAS bf16* Ks = (LAS bf16*)lds; LAS bf16* Vt = (LAS bf16*)(lds + 36864);
    const bf16* Z = (const bf16*)(p->ws + WS_Z); bf16* BR1 = (bf16*)(p->ws + WS_BR) + (size_t)MT * 512;
    const float* qnorm = p->in[8] + l * 64; const float* knorm = p->in[9] + l * 64;
    const int tblk = qb * 128;
    const bf16* qrp = Z + ((size_t)b * SEQ + tblk + 16 * wave + l16) * DIN + C_ZQ + kvh * 256 + 8 * q4;
    bf16x8 qc[2][2];
#pragma unroll
    for (int hh = 0; hh < 2; ++hh) { qc[hh][0] = *(const bf16x8*)(qrp + hh * 64); qc[hh][1] = *(const bf16x8*)(qrp + hh * 64 + 32); }
#pragma unroll
    for (int pass = 0; pass < 2; ++pass) {
        const int jj = pass * 128 + (tid >> 2), sq = tid & 3, tok = tblk - 128 + jj;
        if (tok >= 0) {
            const bf16* zr = Z + (size_t)(b * SEQ + tok) * DIN;
            float y1[8], y2[8];
            float ss = unpack8(*(const bf16x8*)(zr + C_ZK + kvh * 64 + 8 * sq), y1) + unpack8(*(const bf16x8*)(zr + C_ZK + kvh * 64 + 32 + 8 * sq), y2);
            ss += __shfl_xor(ss, 1); ss += __shfl_xor(ss, 2);
            norm_rope8(y1, y2, ss, knorm, sq, (float)tok, 1.f);
            *(LAS bf16x8*)(Ks + jj * 72 + 8 * sq) = pack8(y1); *(LAS bf16x8*)(Ks + jj * 72 + 32 + 8 * sq) = pack8(y2);
            const bf16x8 v1 = *(const bf16x8*)(zr + C_ZV + kvh * 64 + 8 * sq), v2 = *(const bf16x8*)(zr + C_ZV + kvh * 64 + 32 + 8 * sq);
#pragma unroll
            for (int e = 0; e < 8; ++e) { Vt[(8 * sq + e) * 264 + jj] = (bf16)v1[e]; Vt[(32 + 8 * sq + e) * 264 + jj] = (bf16)v2[e]; }
            if (qb == 15 && pass == 1) {
                float* ok = p->out + O_CKP + ((size_t)((l * 8 + b) * 128 + (jj - 128)) * 2 + kvh) * 64;
                float* ov = p->out + O_CVP + ((size_t)((l * 8 + b) * 128 + (jj - 128)) * 2 + kvh) * 64;
#pragma unroll
                for (int e = 0; e < 8; ++e) { ok[8 * sq + e] = y1[e]; ok[32 + 8 * sq + e] = y2[e]; ov[8 * sq + e] = bf2f((unsigned short)v1[e]); ov[32 + 8 * sq + e] = bf2f((unsigned short)v2[e]); }
            }
        } else {
            const bf16x8 z8 = {0, 0, 0, 0, 0, 0, 0, 0};
            *(LAS bf16x8*)(Ks + jj * 72 + 8 * sq) = z8; *(LAS bf16x8*)(Ks + jj * 72 + 32 + 8 * sq) = z8;
#pragma unroll
            for (int e = 0; e < 8; ++e) { Vt[(8 * sq + e) * 264 + jj] = 0; Vt[(32 + 8 * sq + e) * 264 + jj] = 0; }
        }
    }
    LBAR();
    {
        const int qi = 16 * wave + l16; const size_t row = (size_t)b * SEQ + tblk + qi;
        float rc[8], rsn[8]; rope_tab8((float)(tblk + qi), q4, rc, rsn);
        const int kt0 = wave < 6 ? wave : 6;
#pragma unroll 1
        for (int g = 0; g < 4; g += 2) {
            bf16x8 qf[2][2]; float sk[2];
#pragma unroll
            for (int hh = 0; hh < 2; ++hh) { float y1[8], y2[8];
                float ss = unpack8(qc[hh][0], y1) + unpack8(qc[hh][1], y2);
                ss += __shfl_xor(ss, 16); ss += __shfl_xor(ss, 32);
                norm_rope8t(y1, y2, ss, qnorm, q4, rc, rsn, 0.125f * LOG2E);
                qf[hh][0] = pack8(y1); qf[hh][1] = pack8(y2); sk[hh] = p->in[10][l * 8 + kvh * 4 + g + hh] * LOG2E; }
            { const int gn = g < 2 ? g + 2 : 2;
#pragma unroll
                for (int hh = 0; hh < 2; ++hh) { qc[hh][0] = *(const bf16x8*)(qrp + (gn + hh) * 64); qc[hh][1] = *(const bf16x8*)(qrp + (gn + hh) * 64 + 32); } }
            f32x4 o[2][4]; float inv[2];
            attn_core2<10, 264>(Ks, Vt, kt0, qf, qi, qi + 128, qb > 0 ? 0 : 128, sk, o, inv);
#pragma unroll
            for (int hh = 0; hh < 2; ++hh)
#pragma unroll
                for (int dt = 0; dt < 4; ++dt) { u32x2 w; w.x = pk2(o[hh][dt][0] * inv[hh], o[hh][dt][1] * inv[hh]); w.y = pk2(o[hh][dt][2] * inv[hh], o[hh][dt][3] * inv[hh]);
                    *(u32x2*)(BR1 + row * 512 + (kvh * 4 + g + hh) * 64 + 16 * dt + 4 * q4) = w; }
        }
    }
    LBAR();
}

__device__ __forceinline__ void swa_sample_item(KPp p, int l, int item, LAS unsigned char* lds) {
    const int tid = opq_tid(), lane = tid & 63, wave = tid >> 6, l16 = lane & 15, q4 = lane >> 4;
    const int kvh = item & 1, b = item >> 1;
    LAS bf16* Ks = (LAS bf16*)lds; LAS bf16* Vt = (LAS bf16*)(lds + 23040);
    const bf16* Z = (const bf16*)(p->ws + WS_Z); bf16* BR1 = (bf16*)(p->ws + WS_BR) + (size_t)MT * 512;
    const float* qnorm = p->in[8] + l * 64; const float* knorm = p->in[9] + l * 64;
    const float* ck = p->in[3] + (size_t)(l * 128 + b) * 128 * 128; const float* cv = p->in[4] + (size_t)(l * 128 + b) * 128 * 128;
    float* ok = p->out + O_CKS + (size_t)(l * 128 + b) * 128 * 128; float* ov = p->out + O_CVS + (size_t)(l * 128 + b) * 128 * 128;
    const bf16* qr_pre = Z + ((size_t)MP + 4 * b + (l16 >> 2)) * DIN + C_ZQ + (kvh * 4 + (l16 & 3)) * 64;
    const bf16x8 qpre0 = *(const bf16x8*)(qr_pre + 8 * q4), qpre1 = *(const bf16x8*)(qr_pre + 32 + 8 * q4);
    for (int i = tid; i < 28 * 64; i += 512) { const int r = 132 + (i >> 6), c = i & 63; Ks[r * 72 + c] = 0; Vt[c * 168 + r] = 0; }
#pragma unroll
    for (int k = 0; k < 4; ++k) { const int idx = tid + 512 * k, j = idx >> 4, c4 = idx & 15;
        const f32x4 kv = *(const f32x4*)(ck + (size_t)j * 128 + kvh * 64 + 4 * c4), vv = *(const f32x4*)(cv + (size_t)j * 128 + kvh * 64 + 4 * c4);
        u32x2 w; w.x = pk2(kv[0], kv[1]); w.y = pk2(kv[2], kv[3]); *(LAS u32x2*)(Ks + j * 72 + 4 * c4) = w;
#pragma unroll
        for (int e = 0; e < 4; ++e) Vt[(4 * c4 + e) * 168 + j] = f2bf(vv[e]);
        if (j >= 4) { *(f32x4*)(ok + (size_t)(j - 4) * 128 + kvh * 64 + 4 * c4) = kv; *(f32x4*)(ov + (size_t)(j - 4) * 128 + kvh * 64 + 4 * c4) = vv; } }
    if (tid < 16) { const int t = tid >> 2, sq = tid & 3; const bf16* zr = Z + (size_t)(MP + 4 * b + t) * DIN;
        float y1[8], y2[8];
        float ss = unpack8(*(const bf16x8*)(zr + C_ZK + kvh * 64 + 8 * sq), y1) + unpack8(*(const bf16x8*)(zr + C_ZK + kvh * 64 + 32 + 8 * sq), y2);
        ss += __shfl_xor(ss, 1); ss += __shfl_xor(ss, 2);
        norm_rope8(y1, y2, ss, knorm, sq, (float)(PAST + t), 1.f);
        *(LAS bf16x8*)(Ks + (128 + t) * 72 + 8 * sq) = pack8(y1); *(LAS bf16x8*)(Ks + (128 + t) * 72 + 32 + 8 * sq) = pack8(y2);
        const bf16x8 v1 = *(const bf16x8*)(zr + C_ZV + kvh * 64 + 8 * sq), v2 = *(const bf16x8*)(zr + C_ZV + kvh * 64 + 32 + 8 * sq);
#pragma unroll
        for (int e = 0; e < 8; ++e) { Vt[(8 * sq + e) * 168 + 128 + t] = (bf16)v1[e]; Vt[(32 + 8 * sq + e) * 168 + 128 + t] = (bf16)v2[e];
            ok[(size_t)(124 + t) * 128 + kvh * 64 + 8 * sq + e] = y1[e]; ok[(size_t)(124 + t) * 128 + kvh * 64 + 32 + 8 * sq + e] = y2[e];
            ov[(size_t)(124 + t) * 128 + kvh * 64 + 8 * sq + e] = bf2f((unsigned short)v1[e]); ov[(size_t)(124 + t) * 128 + kvh * 64 + 32 + 8 * sq + e] = bf2f((unsigned short)v2[e]); }
    }
    LBAR();
    if (wave == 0) {
        const int t = l16 >> 2, g = l16 & 3, h = kvh * 4 + g; const size_t row = (size_t)MP + 4 * b + t;
        float y1[8], y2[8];
        float ss = unpack8(qpre0, y1) + unpack8(qpre1, y2);
        ss += __shfl_xor(ss, 16); ss += __shfl_xor(ss, 32);
        norm_rope8(y1, y2, ss, qnorm, q4, (float)(PAST + t), 0.125f * LOG2E);
        f32x4 o[4]; float inv;
        attn_core<10, 168, false>(Ks, Vt, 0, pack8(y1), pack8(y2), t, 128 + t, 0, p->in[10][l * 8 + h] * LOG2E, o, inv);
#pragma unroll
        for (int dt = 0; dt < 4; ++dt) { u32x2 w; w.x = pk2(o[dt][0] * inv, o[dt][1] * inv); w.y = pk2(o[dt][2] * inv, o[dt][3] * inv);
            *(u32x2*)(BR1 + row * 512 + h * 64 + 16 * dt + 4 * q4) = w; }
    }
    LBAR();
}

__device__ __forceinline__ float hgrn_lower(const float* lbp, int l, int c) {
    const float v0 = lbp[c], v1 = lbp[512 + c], v2 = lbp[1024 + c], v3 = lbp[1536 + c];
    const float m = fmaxf(fmaxf(v0, v1), fmaxf(v2, v3));
    const float e0 = __expf(v0 - m), e1 = __expf(v1 - m), e2 = __expf(v2 - m), e3 = __expf(v3 - m), inv = 1.f / (e0 + e1 + e2 + e3);
    float cum = 0.f; if (l >= 1) cum += e1; if (l >= 2) cum += e2; if (l >= 3) cum += e3;
    return fmaxf(cum * inv, 0.f);
}

struct P1Raw { unsigned short hf[16], hq[16], hi[16]; };
__device__ __forceinline__ void hgrn_p1_load(KPp p, int ci, P1Raw& r) {
    const int tid = opq_tid(), ch = tid & 127, qt = tid >> 7, n = ci & 31, h = (ci >> 5) & 3, b = ci >> 7;
    const bf16* zr = (const bf16*)(p->ws + WS_Z) + ((size_t)b * SEQ + 64 * n + 16 * qt) * DIN + h * 128 + ch;
#pragma unroll
    for (int tt = 0; tt < 16; ++tt) { r.hf[tt] = zr[(size_t)tt * DIN + C_HF]; r.hq[tt] = zr[(size_t)tt * DIN + C_HQ]; r.hi[tt] = zr[(size_t)tt * DIN + C_HI]; }
}
__device__ __forceinline__ void hgrn_p1_item(KPp p, int l, int ci, LAS unsigned char* lds, const P1Raw& raw) {
    const int tid = opq_tid(), lane = tid & 63, wave = tid >> 6, l16 = lane & 15, q4 = lane >> 4;
    const int ch = tid & 127, qt = tid >> 7, n = ci & 31, h = (ci >> 5) & 3, b = ci >> 7;
    LAS bf16* Qm = (LAS bf16*)lds;
    LAS bf16* Km = (LAS bf16*)(lds + 17408);
    LAS bf16* KlT = (LAS bf16*)(lds + 34816);
    LAS bf16* It = (LAS bf16*)(lds + 53248);
    LAS bf16* As = (LAS bf16*)(lds + 71680);
    LAS float* tot = (LAS float*)(lds + 80896);
    const bf16* Z = (const bf16*)(p->ws + WS_Z); bf16* BR0 = (bf16*)(p->ws + WS_BR);
    const float lb = hgrn_lower(p->in[11], l, h * 128 + ch), oml = 1.f - lb, lbf = fmaxf(lb, 1e-30f);
    const size_t R0 = (size_t)b * SEQ + 64 * n;
    float cs[16], kgv[16]; unsigned short hqv[16], hiv[16];
    { float run = 0.f;
#pragma unroll
        for (int tt = 0; tt < 16; ++tt) { const float zf = bf2f(raw.hf[tt]); hqv[tt] = raw.hq[tt]; hiv[tt] = raw.hi[tt];
            const float ez = __expf(-zf), sg = __builtin_amdgcn_rcpf(1.f + ez); run += __logf(lbf + oml * sg); cs[tt] = run; kgv[tt] = oml * ez * sg; }
        tot[qt * 128 + ch] = run; }
    LBAR();
    { const float t0 = tot[ch], t1 = tot[128 + ch], t2 = tot[256 + ch], t3 = tot[384 + ch];
        const float Gm = t0 + t1, Gl = Gm + t2 + t3, pre = (qt == 0) ? 0.f : (qt == 1) ? t0 : (qt == 2) ? Gm : Gm + t2;
        float kl[16];
#pragma unroll
        for (int tt = 0; tt < 16; ++tt) { const float G = pre + cs[tt], hq = bf2f(hqv[tt]), qv = hq * sigm(hq);
            Qm[(16 * qt + tt) * 136 + ch] = f2bf(qv * __expf(G - Gm)); Km[(16 * qt + tt) * 136 + ch] = f2bf(kgv[tt] * __expf(Gm - G)); kl[tt] = kgv[tt] * __expf(Gl - G);
            BR0[(R0 + 16 * qt + tt) * 512 + h * 128 + ch] = f2bf(qv * __expf(G)); }
        u32x4 w0, w1; w0.x = pk2(kl[0], kl[1]); w0.y = pk2(kl[2], kl[3]); w0.z = pk2(kl[4], kl[5]); w0.w = pk2(kl[6], kl[7]);
        w1.x = pk2(kl[8], kl[9]); w1.y = pk2(kl[10], kl[11]); w1.z = pk2(kl[12], kl[13]); w1.w = pk2(kl[14], kl[15]);
        *(LAS u32x4*)(KlT + ch * 72 + 16 * qt) = w0; *(LAS u32x4*)(KlT + ch * 72 + 16 * qt + 8) = w1;
        u32x4 i0, i1;
        i0.x = hiv[0] | ((unsigned)hiv[1] << 16); i0.y = hiv[2] | ((unsigned)hiv[3] << 16); i0.z = hiv[4] | ((unsigned)hiv[5] << 16); i0.w = hiv[6] | ((unsigned)hiv[7] << 16);
        i1.x = hiv[8] | ((unsigned)hiv[9] << 16); i1.y = hiv[10] | ((unsigned)hiv[11] << 16); i1.z = hiv[12] | ((unsigned)hiv[13] << 16); i1.w = hiv[14] | ((unsigned)hiv[15] << 16);
        *(LAS u32x4*)(It + ch * 72 + 16 * qt) = i0; *(LAS u32x4*)(It + ch * 72 + 16 * qt + 8) = i1;
        if (qt == 0) ((float*)(p->ws + WS_DV))[(size_t)ci * 128 + ch] = __expf(Gl); }
    LBAR();
    {
#pragma unroll
        for (int k2 = 0; k2 < 2; ++k2) { const int st = wave & 3, tq = (wave >> 2) * 2 + k2; f32x4 a = (f32x4){0.f, 0.f, 0.f, 0.f};
            if (st <= tq) {
#pragma unroll
                for (int ks = 0; ks < 4; ++ks) a = mfma16(*(const LAS bf16x8*)(Km + (16 * st + l16) * 136 + 32 * ks + 8 * q4), *(const LAS bf16x8*)(Qm + (16 * tq + l16) * 136 + 32 * ks + 8 * q4), a);
                const int t = 16 * tq + l16, s0 = 16 * st + 4 * q4;
#pragma unroll
                for (int r = 0; r < 4; ++r) a[r] = (s0 + r <= t) ? a[r] : 0.f; }
            u32x2 w; w.x = pk2(a[0], a[1]); w.y = pk2(a[2], a[3]); *(LAS u32x2*)(As + (16 * tq + l16) * 72 + 16 * st + 4 * q4) = w; } }
    LBAR();
    {
        const int tq = wave & 3, eh = wave >> 2;
        f32x4 o[4];
#pragma unroll
        for (int et = 0; et < 4; ++et) o[et] = (f32x4){0.f, 0.f, 0.f, 0.f};
#pragma unroll
        for (int ks = 0; ks < 2; ++ks) { const bf16x8 bq = *(const LAS bf16x8*)(As + (16 * tq + l16) * 72 + 32 * ks + 8 * q4);
#pragma unroll
            for (int et = 0; et < 4; ++et) o[et] = mfma16(*(const LAS bf16x8*)(It + (64 * eh + 16 * et + l16) * 72 + 32 * ks + 8 * q4), bq, o[et]); }
        u32x2* oi = (u32x2*)(p->ws + WS_OI) + (size_t)ci * 2048 + (size_t)(wave * 4) * 64 + lane;
#pragma unroll
        for (int et = 0; et < 4; ++et) { u32x2 w; w.x = pk2(o[et][0], o[et][1]); w.y = pk2(o[et][2], o[et][3]); oi[et * 64] = w; } }
    {
        f32x4 L[8];
#pragma unroll
        for (int et = 0; et < 8; ++et) L[et] = (f32x4){0.f, 0.f, 0.f, 0.f};
#pragma unroll
        for (int ks = 0; ks < 2; ++ks) { const bf16x8 a = *(const LAS bf16x8*)(KlT + (16 * wave + l16) * 72 + 32 * ks + 8 * q4);
#pragma unroll
            for (int et = 0; et < 8; ++et) L[et] = mfma16(a, *(const LAS bf16x8*)(It + (16 * et + l16) * 72 + 32 * ks + 8 * q4), L[et]); }
        u32x2* lo = (u32x2*)(p->ws + WS_G) + (size_t)ci * 4096 + (size_t)(wave * 8) * 64 + lane;
#pragma unroll
        for (int et = 0; et < 8; ++et) { u32x2 w; w.x = pk2(L[et][0], L[et][1]); w.y = pk2(L[et][2], L[et][3]); lo[et * 64] = w; } }
    LBAR();
}
__device__ __forceinline__ void hgrn_p2(KPp p, int l, int bh, int tr, int tb) {
    const int tid = opq_tid();
    const u32x2* LST = (const u32x2*)(p->ws + WS_G); u32x2* SST = (u32x2*)(p->ws + WS_G + WS_SST_OFF); const float* DV = (const float*)(p->ws + WS_DV);
#pragma unroll 1
    for (int g4 = tr * 512 + tid; g4 < 4096; g4 += tb * 512) {
        const int w = g4 >> 9, et = (g4 >> 6) & 7, lane = g4 & 63, d0 = 16 * w + 4 * (lane >> 4), e = 16 * et + (lane & 15);
        f32x4 S = (f32x4){0.f, 0.f, 0.f, 0.f};
#pragma unroll
        for (int n = 0; n < 32; ++n) { const size_t ci = (size_t)bh * 32 + n;
            u32x2 w2; w2.x = pk2(S[0], S[1]); w2.y = pk2(S[2], S[3]); SST[ci * 4096 + g4] = w2;
            const u32x2 lz = LST[ci * 4096 + g4]; const f32x4 dv = *(const f32x4*)(DV + ci * 128 + d0);
            const f32x4 L = (f32x4){__uint_as_float(lz.x << 16), __uint_as_float(lz.x & 0xffff0000u), __uint_as_float(lz.y << 16), __uint_as_float(lz.y & 0xffff0000u)};
            S = dv * S + L; }
        float* so = p->out + O_SHP + (size_t)(l * 32 + bh) * 16384;
#pragma unroll
        for (int r = 0; r < 4; ++r) so[(size_t)(d0 + r) * 128 + e] = S[r];
    }
}
__device__ __forceinline__ void hgrn_p3_item(KPp p, int l, int ci, LAS unsigned char* lds, bool dry) {
    const int tid = opq_tid(), lane = tid & 63, wave = tid >> 6, l16 = lane & 15, q4 = lane >> 4;
    const int n = ci & 31, h = (ci >> 5) & 3, b = ci >> 7;
    LAS bf16* Qs = (LAS bf16*)lds;
    LAS float* ssp = (LAS float*)(lds + 17408);
    const bf16* Z = (const bf16*)(p->ws + WS_Z); bf16* BR0 = (bf16*)(p->ws + WS_BR);
    const size_t R0 = (size_t)b * SEQ + 64 * n;
#pragma unroll
    for (int k = 0; k < 2; ++k) { const int idx = tid + 512 * k, t = idx >> 4, c8 = idx & 15;
        *(LAS u32x4*)(Qs + t * 136 + 8 * c8) = *(const u32x4*)(BR0 + (R0 + t) * 512 + h * 128 + 8 * c8); }
    const int tq = wave & 3, eh = wave >> 2;
    f32x4 o[4];
    { const u32x2* oi = (const u32x2*)(p->ws + WS_OI) + (size_t)ci * 2048 + (size_t)(wave * 4) * 64 + lane;
#pragma unroll
        for (int et = 0; et < 4; ++et) { const u32x2 w = oi[et * 64]; o[et][0] = __uint_as_float(w.x << 16); o[et][1] = __uint_as_float(w.x & 0xffff0000u); o[et][2] = __uint_as_float(w.y << 16); o[et][3] = __uint_as_float(w.y & 0xffff0000u); } }
    const u32x2* sst = (const u32x2*)(p->ws + WS_G + WS_SST_OFF) + (size_t)ci * 4096 + lane;
    u32x2 sa[4][4][2];
#pragma unroll
    for (int w2 = 0; w2 < 4; ++w2)
#pragma unroll
        for (int et = 0; et < 4; ++et) { sa[w2][et][0] = sst[((2 * w2) * 8 + 4 * eh + et) * 64]; sa[w2][et][1] = sst[((2 * w2 + 1) * 8 + 4 * eh + et) * 64]; }
    u32x2 hzv[4]; f32x4 onv[4];
    { const size_t rowh = R0 + 16 * tq + l16; const float* onorm = p->in[12] + l * 128;
#pragma unroll
        for (int et = 0; et < 4; ++et) { const int e0 = 64 * eh + 16 * et + 4 * q4; hzv[et] = *(const u32x2*)(Z + rowh * DIN + C_HG + h * 128 + e0); onv[et] = *(const f32x4*)(onorm + e0); } }
    LBAR();
#pragma unroll
    for (int w2 = 0; w2 < 4; ++w2) { const LAS bf16* qp = Qs + (16 * tq + l16) * 136 + 32 * w2 + 4 * q4;
        const u32x2 b0 = *(const LAS u32x2*)qp, b1 = *(const LAS u32x2*)(qp + 16);
        u32x4 bw; bw.x = b0.x; bw.y = b0.y; bw.z = b1.x; bw.w = b1.y;
#pragma unroll
        for (int et = 0; et < 4; ++et) { u32x4 aw; aw.x = sa[w2][et][0].x; aw.y = sa[w2][et][0].y; aw.z = sa[w2][et][1].x; aw.w = sa[w2][et][1].y;
            o[et] = mfma16(__builtin_bit_cast(bf16x8, aw), __builtin_bit_cast(bf16x8, bw), o[et]); } }
    { float s = 0.f;
#pragma unroll
        for (int et = 0; et < 4; ++et) s += (o[et][0] * o[et][0] + o[et][1] * o[et][1]) + (o[et][2] * o[et][2] + o[et][3] * o[et][3]);
        s += __shfl_xor(s, 16); s += __shfl_xor(s, 32);
        if (q4 == 0) ssp[eh * 64 + 16 * tq + l16] = s; }
    LBAR();
    { const int t = 16 * tq + l16; const float rstd = rsqrtf((ssp[t] + ssp[64 + t]) * (1.f / 128.f) + 1e-6f); const size_t row = R0 + t;
#pragma unroll
        for (int et = 0; et < 4; ++et) { const int e0 = 64 * eh + 16 * et + 4 * q4;
            const u32x2 hz = hzv[et]; const f32x4 on = onv[et];
            const float g0 = __uint_as_float(hz.x << 16), g1 = __uint_as_float(hz.x & 0xffff0000u), g2 = __uint_as_float(hz.y << 16), g3 = __uint_as_float(hz.y & 0xffff0000u);
            u32x2 w; w.x = pk2(o[et][0] * rstd * on[0] * g0 * sigm(g0), o[et][1] * rstd * on[1] * g1 * sigm(g1)); w.y = pk2(o[et][2] * rstd * on[2] * g2 * sigm(g2), o[et][3] * rstd * on[3] * g3 * sigm(g3));
            if (!dry) *(u32x2*)(BR0 + row * 512 + h * 128 + e0) = w; } }
    LBAR();
}

__device__ __forceinline__ void hgrn_sample_item(KPp p, int l, int item, LAS unsigned char* lds) {
    const int tid = opq_tid(), lane = tid & 63, wave = tid >> 6;
    const int e = tid & 127, dg = tid >> 7, b = item >> 2, h = item & 3;
    LAS float* fv = (LAS float*)lds;
    LAS float* kv = fv + 512;
    LAS float* qv = kv + 512;
    LAS float* iv = qv + 512;
    LAS float* part = iv + 512;
    LAS float* wsum = part + 2048;
    const bf16* Z = (const bf16*)(p->ws + WS_Z); bf16* BR0 = (bf16*)(p->ws + WS_BR);
    const float* S0 = p->in[2] + (size_t)((l * 128 + b) * 4 + h) * 16384;
    float* So = p->out + O_SHS + (size_t)((l * 128 + b) * 4 + h) * 16384;
    float s[32];
#pragma unroll
    for (int k = 0; k < 32; ++k) s[k] = S0[(size_t)(32 * dg + k) * 128 + e];
    const unsigned short hg_raw = Z[((size_t)MP + 4 * b + dg) * DIN + C_HG + h * 128 + e]; const float on_pre = p->in[12][l * 128 + e];
    { const int t = dg, d = e; const float lb = hgrn_lower(p->in[11], l, h * 128 + d), oml = 1.f - lb;
        const bf16* zr = Z + (size_t)(MP + 4 * b + t) * DIN + h * 128 + d;
        const float zf = bf2f(zr[C_HF]), hq = bf2f(zr[C_HQ]), ez = __expf(-zf), sg = __builtin_amdgcn_rcpf(1.f + ez);
        fv[t * 128 + d] = fmaxf(lb, 1e-30f) + oml * sg; kv[t * 128 + d] = oml * ez * sg; qv[t * 128 + d] = hq * sigm(hq); iv[t * 128 + d] = bf2f(zr[C_HI]); }
    LBAR();
#pragma unroll
    for (int t = 0; t < 4; ++t) { const float ii = iv[t * 128 + e]; float po = 0.f;
#pragma unroll
        for (int k = 0; k < 32; ++k) { const int d = 32 * dg + k; s[k] = fv[t * 128 + d] * s[k] + kv[t * 128 + d] * ii; po += s[k] * qv[t * 128 + d]; }
        part[(t * 4 + dg) * 128 + e] = po; }
#pragma unroll
    for (int k = 0; k < 32; ++k) So[(size_t)(32 * dg + k) * 128 + e] = s[k];
    LBAR();
    { const int t = dg; const float o = (part[(t * 4 + 0) * 128 + e] + part[(t * 4 + 1) * 128 + e]) + (part[(t * 4 + 2) * 128 + e] + part[(t * 4 + 3) * 128 + e]);
        float ss = o * o;
#pragma unroll
        for (int k = 1; k < 64; k <<= 1) ss += __shfl_xor(ss, k);
        if (lane == 0) wsum[wave] = ss;
        LBAR();
        const float rstd = rsqrtf((wsum[2 * t] + wsum[2 * t + 1]) * (1.f / 128.f) + 1e-6f);
        const size_t row = (size_t)MP + 4 * b + t; const float hg = bf2f(hg_raw);
        BR0[row * 512 + h * 128 + e] = f2bf(o * rstd * on_pre * hg * sigm(hg)); }
    LBAR();
}

template <int NTT>
__device__ __forceinline__ void pool_mma(KPp p, int l, int g, const LAS bf16* Dl, size_t row_base, int row_stride_unused) {
    const int tid_ = opq_tid(); const int lane = tid_ & 63, wave = tid_ >> 6, l16 = lane & 15, q4 = lane >> 4;
    const bf16* Wp = (const bf16*)(p->ws + WS_WPL) + (size_t)(l * 4 + g) * 16384;
    bf16* BR2 = (bf16*)(p->ws + WS_BR) + (size_t)2 * MT * 512;
    const float* scale = p->in[14] + l * 512 + g * 128;
    for (int tile = wave; tile < NTT * 8; tile += 8) { const int tt = tile % NTT, nt = tile / NTT;
        f32x4 a = (f32x4){0.f, 0.f, 0.f, 0.f};
#pragma unroll
        for (int ks = 0; ks < 4; ++ks) a = mfma16(*(const bf16x8*)(Wp + (size_t)(16 * nt + l16) * 128 + 32 * ks + 8 * q4), *(const LAS bf16x8*)(Dl + (16 * tt + l16) * 136 + 32 * ks + 8 * q4), a);
        const f32x4 sv = *(const f32x4*)(scale + 16 * nt + 4 * q4);
        u32x2 w; w.x = pk2(a[0] * sv[0], a[1] * sv[1]); w.y = pk2(a[2] * sv[2], a[3] * sv[3]);
        *(u32x2*)(BR2 + (row_base + 16 * tt + l16) * 512 + g * 128 + 16 * nt + 4 * q4) = w; }
}
__device__ __forceinline__ void pool_prompt_item(KPp p, int l, int item, LAS unsigned char* lds) {
    const int tid = opq_tid(), lane = tid & 63, wave = tid >> 6, l16 = lane & 15, q4 = lane >> 4;
    const int g = item & 3, tile = item >> 2, b = tile >> 4, t0 = (tile & 15) * 128, w = 2 << g;
    LAS float* U = (LAS float*)lds;
    LAS bf16* Dl = (LAS bf16*)(lds + 73216);
    const bf16* Z = (const bf16*)(p->ws + WS_Z);
    const bf16* Wp = (const bf16*)(p->ws + WS_WPL) + (size_t)(l * 4 + g) * 16384;
    bf16x8 wa[4];
#pragma unroll
    for (int ks = 0; ks < 4; ++ks) wa[ks] = *(const bf16x8*)(Wp + (size_t)(16 * wave + l16) * 128 + 32 * ks + 8 * q4);
    const f32x4 sv = *(const f32x4*)(p->in[14] + l * 512 + g * 128 + 16 * wave + 4 * q4);
#pragma unroll 1
    for (int idx = tid; idx < 143 * 16; idx += 512) { const int r = idx >> 4, c8 = idx & 15, tok = t0 - 15 + r;
        float y[8];
        if (tok >= 0) { unpack8(*(const bf16x8*)(Z + (size_t)(b * SEQ + tok) * DIN + C_U + g * 128 + 8 * c8), y); }
        else {
#pragma unroll
            for (int e = 0; e < 8; ++e) y[e] = 0.f; }
        *(LAS f32x4*)(U + r * 128 + 8 * c8) = (f32x4){y[0], y[1], y[2], y[3]}; *(LAS f32x4*)(U + r * 128 + 8 * c8 + 4) = (f32x4){y[4], y[5], y[6], y[7]}; }
    LBAR();
    { const int c = tid & 127, tq = tid >> 7, tf = 32 * tq;
        float s = 0.f;
        for (int k = 0; k < w; ++k) s += U[(15 + tf - k) * 128 + c];
        const float invw = 1.f / (float)w;
#pragma unroll 4
        for (int t = tf; t < tf + 32; ++t) { const int tok = t0 + t; const float cur = U[(15 + t) * 128 + c];
            const float inv = (tok + 1 >= w) ? invw : 1.f / (float)(tok + 1);
            Dl[t * 136 + c] = f2bf(s * inv - cur);
            const float add = (t < 127) ? U[(16 + t) * 128 + c] : 0.f;
            s += add - U[(16 + t - w) * 128 + c]; }
        if (t0 == SEQ - 128) {
            for (int idx = tid; idx < 15 * 128; idx += 512) { const int r = idx >> 7, cc = idx & 127; p->out[O_SPP + ((size_t)(l * 8 + b) * 15 + r) * 512 + g * 128 + cc] = U[(15 + 113 + r) * 128 + cc]; } } }
    LBAR();
    { bf16* BR2 = (bf16*)(p->ws + WS_BR) + (size_t)2 * MT * 512; const size_t rb = (size_t)b * SEQ + t0;
#pragma unroll
        for (int tt = 0; tt < 8; ++tt) { f32x4 a = (f32x4){0.f, 0.f, 0.f, 0.f};
#pragma unroll
            for (int ks = 0; ks < 4; ++ks) a = mfma16(wa[ks], *(const LAS bf16x8*)(Dl + (16 * tt + l16) * 136 + 32 * ks + 8 * q4), a);
            u32x2 wv; wv.x = pk2(a[0] * sv[0], a[1] * sv[1]); wv.y = pk2(a[2] * sv[2], a[3] * sv[3]);
            *(u32x2*)(BR2 + (rb + 16 * tt + l16) * 512 + g * 128 + 16 * wave + 4 * q4) = wv; } }
    LBAR();
}
__device__ __forceinline__ void pool_sample_item(KPp p, int l, int item, LAS unsigned char* lds) {
    const int tid = opq_tid(); const int g = item & 3, b0 = (item >> 2) * 4, w = 2 << g;
    LAS float* U = (LAS float*)lds;
    LAS bf16* Dl = (LAS bf16*)(lds + 40448);
    const bf16* Z = (const bf16*)(p->ws + WS_Z);
    for (int idx = tid; idx < 4 * 19 * 128; idx += 512) { const int c = idx & 127, r = (idx >> 7) % 19, bb = (idx >> 7) / 19, b = b0 + bb;
        float v;
        if (r < 15) v = p->in[5][((size_t)(l * 128 + b) * 15 + r) * 512 + g * 128 + c];
        else v = bf2f(Z[(size_t)(MP + 4 * b + (r - 15)) * DIN + C_U + g * 128 + c]);
        U[idx] = v;
        if (r >= 4) p->out[O_SPS + ((size_t)(l * 128 + b) * 15 + (r - 4)) * 512 + g * 128 + c] = v; }
    LBAR();
    for (int idx = tid; idx < 16 * 128; idx += 512) { const int c = idx & 127, rt = idx >> 7, bb = rt >> 2, t = rt & 3;
        float s = 0.f; for (int k = 0; k < w; ++k) s += U[(bb * 19 + 15 + t - k) * 128 + c];
        Dl[rt * 136 + c] = f2bf(s / (float)w - U[(bb * 19 + 15 + t) * 128 + c]); }
    LBAR();
    pool_mma<1>(p, l, g, Dl, (size_t)MP + 4 * b0, 0);
    LBAR();
}

#define XB_TMO      128
#define XB_XCNT(j)  (256  + 64 * (j))
#define XB_XSUB(j)  (1280 + 64 * (j))
#define XB_XGEN(j)  (2304 + 64 * (j))
#define XB_TOP      3328
#define XB_TOPGEN   3392
#define XCD_BAR_WORDS 3456
#define XB_SPIN_CAP (1u << 18)

__device__ __forceinline__ unsigned xb_ld(unsigned* p)              { return __hip_atomic_load(p, __ATOMIC_RELAXED, __HIP_MEMORY_SCOPE_AGENT); }
__device__ __forceinline__ unsigned xb_add(unsigned* p, unsigned v) { return __hip_atomic_fetch_add(p, v, __ATOMIC_RELAXED, __HIP_MEMORY_SCOPE_AGENT); }
__device__ __forceinline__ unsigned xb_xcc_id() { return (unsigned)__builtin_amdgcn_s_getreg((3 << 11) | 20) & 0xFu; }
#define XB_SPIN(cond, bar) do { unsigned _sp = 0; while (cond) { __builtin_amdgcn_s_sleep(1); \
    if ((++_sp & 255u) == 0u) { if (xb_ld(&(bar)[XB_TMO])) break; if (_sp > XB_SPIN_CAP) { atomicAdd(&(bar)[XB_TMO], 1u); break; } } } } while (0)

struct XcdBarrier {
    unsigned* bar; unsigned x;
    volatile LAS unsigned* st;
};

__device__ __forceinline__ XcdBarrier xcd_barrier_post(unsigned* bar, volatile LAS unsigned* st) {
    XcdBarrier b; b.bar = bar; b.x = xb_xcc_id(); b.st = st;
    if (threadIdx.x == 0) (void)xb_add(&bar[XB_XCNT(b.x)], 1u);
    return b;
}
__device__ __forceinline__ void xcd_barrier_complete(unsigned* bar, unsigned x, unsigned& nloc, unsigned& nx) {
    const unsigned G = gridDim.x * gridDim.y * gridDim.z;
    unsigned sum, cnt, mine, sp = 0u;
    for (;;) {
        sum = 0u; cnt = 0u; mine = 0u;
#pragma unroll
        for (unsigned j = 0; j < 16; ++j) { const unsigned c = xb_ld(&bar[XB_XCNT(j)]); sum += c; cnt += (c > 0u) ? 1u : 0u; mine = (j == x) ? c : mine; }
        if (sum == G) break;
        __builtin_amdgcn_s_sleep(1);
        if ((++sp & 255u) == 0u) { if (xb_ld(&bar[XB_TMO])) break; if (sp > XB_SPIN_CAP) { atomicAdd(&bar[XB_TMO], 1u); break; } }
    }
    nloc = mine > 0u ? mine : 1u; nx = cnt > 0u ? cnt : 1u;
}

__device__ __forceinline__ void xcd_barrier(const XcdBarrier& b) {
    asm volatile("s_waitcnt vmcnt(0)" ::: "memory");
    __syncthreads();
    if (threadIdx.x == 0) {
        unsigned* bar = b.bar;
        __builtin_amdgcn_s_waitcnt(0);
        unsigned nloc = b.st[0], nx = b.st[1];
        if (nloc == 0u) { xcd_barrier_complete(bar, b.x, nloc, nx); b.st[0] = nloc; b.st[1] = nx; }
        const unsigned old = xb_add(&bar[XB_XSUB(b.x)], 1u);
        const unsigned gen = old / nloc;
        if (old + 1u == (gen + 1u) * nloc) {
            __builtin_amdgcn_fence(__ATOMIC_RELEASE, "agent");
            asm volatile("s_waitcnt vmcnt(0)" ::: "memory");
            const unsigned og = xb_add(&bar[XB_TOP], 1u);
            const unsigned tg = og / nx;
            if (og + 1u == (tg + 1u) * nx) xb_add(&bar[XB_TOPGEN], 1u);
            else XB_SPIN(xb_ld(&bar[XB_TOPGEN]) == tg, bar);
            __builtin_amdgcn_fence(__ATOMIC_ACQUIRE, "agent");
            xb_add(&bar[XB_XGEN(b.x)], 1u);
            asm volatile("s_waitcnt vmcnt(0)" ::: "memory");
        } else {
            XB_SPIN(xb_ld(&bar[XB_XGEN(b.x)]) == gen, bar);
            __builtin_amdgcn_fence(__ATOMIC_ACQUIRE, "agent");
            asm volatile("s_waitcnt vmcnt(0)" ::: "memory");
        }
    }
    __syncthreads();
}

__device__ __forceinline__ f32x4 tail_core(const bf16* A, const bf16* Bt, int K, LAS f32x4* red) {
    const int tid = opq_tid(), lane = tid & 63, wave = tid >> 6, l16 = lane & 15, q4 = lane >> 4;
    const int kper = K >> 3;
    f32x4 acc[2][4];
#pragma unroll
    for (int mt = 0; mt < 2; ++mt)
#pragma unroll
        for (int nt = 0; nt < 4; ++nt) acc[mt][nt] = (f32x4){0.f, 0.f, 0.f, 0.f};
    const bf16* ap = A + (size_t)l16 * K + wave * kper + 16 * q4;
    const bf16* bp = Bt + (size_t)l16 * K + wave * kper + 16 * q4;
#pragma unroll 4
    for (int k = 0; k < kper; k += 64) {
        bf16x8 a[2][2], b[4][2];
#pragma unroll
        for (int mt = 0; mt < 2; ++mt) { a[mt][0] = *(const bf16x8*)(ap + (size_t)mt * 16 * K + k); a[mt][1] = *(const bf16x8*)(ap + (size_t)mt * 16 * K + k + 8); }
#pragma unroll
        for (int nt = 0; nt < 4; ++nt) { b[nt][0] = *(const bf16x8*)(bp + (size_t)nt * 16 * K + k); b[nt][1] = *(const bf16x8*)(bp + (size_t)nt * 16 * K + k + 8); }
#pragma unroll
        for (int h2 = 0; h2 < 2; ++h2)
#pragma unroll
            for (int mt = 0; mt < 2; ++mt)
#pragma unroll
                for (int nt = 0; nt < 4; ++nt) acc[mt][nt] = mfma16(b[nt][h2], a[mt][h2], acc[mt][nt]);
    }
#pragma unroll
    for (int mt = 0; mt < 2; ++mt)
#pragma unroll
        for (int nt = 0; nt < 4; ++nt) red[(wave * 8 + mt * 4 + nt) * 64 + lane] = acc[mt][nt];
    __syncthreads();
    f32x4 sum = red[wave * 64 + lane];
#pragma unroll
    for (int w = 1; w < 8; ++w) sum += red[(w * 8 + wave) * 64 + lane];
    __syncthreads();
    return sum;
}
__device__ __forceinline__ void tail_branch(KPp p, int l, LAS unsigned char* lds) {
#pragma unroll 1
    for (int piece = blockIdx.x; piece < 256; piece += gridDim.x) {
        const int tid = opq_tid(), lane = tid & 63, wave = tid >> 6, l16 = lane & 15, q4 = lane >> 4;
        const int mb = piece >> 4, nb = piece & 15, row = MP + 32 * mb + 16 * (wave >> 2) + l16, c = 64 * nb + 16 * (wave & 3) + 4 * q4;
        const bf16* Z = (const bf16*)(p->ws + WS_Z);
        f32x4 tot = (f32x4){0.f, 0.f, 0.f, 0.f};
#pragma unroll 1
        for (int br = 0; br < 3; ++br) {
            const f32x4 v = tail_core((const bf16*)(p->ws + WS_BR) + ((size_t)br * MT + MP + 32 * mb) * 512, (const bf16*)(p->ws + WS_WBR) + ((size_t)(l * 3 + br) * 1024 + 64 * nb) * 512, 512, (LAS f32x4*)lds);
            const u32x2 gz = *(const u32x2*)(Z + (size_t)row * DIN + C_ZG + br * 1024 + c);
            tot[0] += v[0] * sigm(__uint_as_float(gz.x << 16)); tot[1] += v[1] * sigm(__uint_as_float(gz.x & 0xffff0000u));
            tot[2] += v[2] * sigm(__uint_as_float(gz.y << 16)); tot[3] += v[3] * sigm(__uint_as_float(gz.y & 0xffff0000u)); }
        u32x2 w; w.x = pk2(tot[0], tot[1]); w.y = pk2(tot[2], tot[3]);
        *(u32x2*)((bf16*)(p->ws + WS_G) + (size_t)row * 1024 + c) = w;
    }
}
__device__ __forceinline__ void tail_resid(KPp p, const bf16* A, const bf16* Bt, int K, const bf16* res, bf16* xo, float* Xf, float* rowss, LAS unsigned char* lds) {
#pragma unroll 1
    for (int piece = blockIdx.x; piece < 256; piece += gridDim.x) {
        const int tid = opq_tid(), lane = tid & 63, wave = tid >> 6, l16 = lane & 15, q4 = lane >> 4;
        const int mb = piece >> 4, nb = piece & 15, mt = wave >> 2, nt = wave & 3, row = MP + 32 * mb + 16 * mt + l16, c = 64 * nb + 16 * nt + 4 * q4;
        f32x4 x = tail_core(A + (size_t)(MP + 32 * mb) * K, Bt + (size_t)(64 * nb) * K, K, (LAS f32x4*)lds);
        const u32x2 rz = *(const u32x2*)(res + (size_t)row * 1024 + c);
        x[0] += __uint_as_float(rz.x << 16); x[1] += __uint_as_float(rz.x & 0xffff0000u); x[2] += __uint_as_float(rz.y << 16); x[3] += __uint_as_float(rz.y & 0xffff0000u);
        if (Xf) *(f32x4*)(Xf + (size_t)row * 1024 + c) = x;
        u32x2 w; w.x = pk2(x[0], x[1]); w.y = pk2(x[2], x[3]); *(u32x2*)(xo + (size_t)row * 1024 + c) = w;
        LAS float* part = (LAS float*)lds;
        part[(16 * mt + l16) * 16 + nt * 4 + q4] = (x[0] * x[0] + x[1] * x[1]) + (x[2] * x[2] + x[3] * x[3]);
        __syncthreads();
        if (tid < 32) { float ssum = 0.f;
#pragma unroll
            for (int k = 0; k < 16; ++k) ssum += part[tid * 16 + k];
            rowss[(size_t)(MP + 32 * mb + tid) * 16 + nb] = ssum; }
        __syncthreads();
    }
}

__device__ __forceinline__ void tail_up(KPp p, int l, const float* rowss, LAS unsigned char* lds) {
#pragma unroll 1
    for (int piece = blockIdx.x; piece < 256; piece += gridDim.x) {
        const int tid = opq_tid(), lane = tid & 63, wave = tid >> 6, l16 = lane & 15, q4 = lane >> 4;
        const int mb = piece >> 5, nb = piece & 31;
        const bf16* A = (const bf16*)(p->ws + WS_BR) + (size_t)(MP + 64 * mb) * 1024;
#pragma unroll
        for (int i = 0; i < 16; ++i) { const int idx = tid + 512 * i, r = idx >> 7, c = idx & 127;
            *(LAS u32x4*)(lds + r * 2048 + ((c ^ (r & 15)) << 4)) = *(const u32x4*)(A + (size_t)r * 1024 + 8 * c); }
        LBAR();
        const bf16* bp = (const bf16*)(p->ws + WS_WUP) + ((size_t)l * 4096 + 128 * nb + 16 * wave + l16) * 1024 + 16 * q4;
        f32x4 acc[4];
#pragma unroll
        for (int mt = 0; mt < 4; ++mt) acc[mt] = (f32x4){0.f, 0.f, 0.f, 0.f};
#pragma unroll 8
        for (int kb = 0; kb < 16; ++kb) {
            const bf16x8 b0 = *(const bf16x8*)(bp + 64 * kb), b1 = *(const bf16x8*)(bp + 64 * kb + 8);
#pragma unroll
            for (int mt = 0; mt < 4; ++mt) { acc[mt] = mfma16(b0, *(const LAS bf16x8*)(lds + (16 * mt + l16) * 2048 + (((8 * kb + 2 * q4) ^ l16) << 4)), acc[mt]);
                acc[mt] = mfma16(b1, *(const LAS bf16x8*)(lds + (16 * mt + l16) * 2048 + (((8 * kb + 2 * q4 + 1) ^ l16) << 4)), acc[mt]); } }
        bf16* H = (bf16*)(p->ws + WS_Z);
#pragma unroll
        for (int mt = 0; mt < 4; ++mt) { const size_t row = (size_t)MP + 64 * mb + 16 * mt + l16;
            const f32x4 r0 = *(const f32x4*)(rowss + row * 16), r1 = *(const f32x4*)(rowss + row * 16 + 4), r2 = *(const f32x4*)(rowss + row * 16 + 8), r3 = *(const f32x4*)(rowss + row * 16 + 12);
            const float rsum = (((r0[0] + r0[1]) + (r0[2] + r0[3])) + ((r1[0] + r1[1]) + (r1[2] + r1[3]))) + (((r2[0] + r2[1]) + (r2[2] + r2[3])) + ((r3[0] + r3[1]) + (r3[2] + r3[3])));
            const float rs = rsqrtf(rsum * (1.0f / 1024.0f) + 1e-6f);
            float v[4];
#pragma unroll
            for (int j = 0; j < 4; ++j) { const float a = fmaxf(acc[mt][j] * rs, 0.f); v[j] = a * a; }
            u32x2 w; w.x = pk2(v[0], v[1]); w.y = pk2(v[2], v[3]);
            *(u32x2*)(H + row * 4096 + 128 * nb + 16 * wave + 4 * q4) = w; }
        LBAR();
    }
}

__device__ __forceinline__ void team_barrier(unsigned* cnt, unsigned target) {
    asm volatile("s_waitcnt vmcnt(0)" ::: "memory");
    __syncthreads();
    if (threadIdx.x == 0) {
        __builtin_amdgcn_fence(__ATOMIC_RELEASE, "agent");
        asm volatile("s_waitcnt vmcnt(0)" ::: "memory");
        (void)__hip_atomic_fetch_add(cnt, 1u, __ATOMIC_RELAXED, __HIP_MEMORY_SCOPE_AGENT);
        unsigned sp = 0u;
        while (__hip_atomic_load(cnt, __ATOMIC_RELAXED, __HIP_MEMORY_SCOPE_AGENT) < target) { __builtin_amdgcn_s_sleep(1); if (++sp > (1u << 22)) break; }
        __builtin_amdgcn_fence(__ATOMIC_ACQUIRE, "agent");
        asm volatile("s_waitcnt vmcnt(0)" ::: "memory");
    }
    __syncthreads();
}
__device__ __forceinline__ void mixers(KPp p, int l, LAS unsigned char* lds) {
    const int nb = gridDim.x, bid = blockIdx.x, tb = nb / 32, team = bid / tb, tr = bid - team * tb;
    constexpr int N_SP = 256, N_PP = 512, N_HS = 512, N_SS = 256, N_PS = 128;
    unsigned* tcnt = (unsigned*)(p->ws + WS_CTL + 16384) + team * 64;
    { P1Raw cur; hgrn_p1_load(p, team * 32 + (tr < 32 ? tr : 31), cur);
#pragma unroll 1
        for (int n = tr; n < 32; n += tb) { P1Raw nxt; const int nn = n + tb; hgrn_p1_load(p, team * 32 + (nn < 32 ? nn : 31), nxt); hgrn_p1_item(p, l, team * 32 + n, lds, cur); cur = nxt; } }
#pragma unroll 1
    for (int it = bid; it < N_SP; it += nb) swa_prompt_item(p, l, it, lds);
    team_barrier(tcnt, (unsigned)(tb * (2 * l + 1)));
    hgrn_p2(p, l, team, tr, tb);
#pragma unroll 1
    for (int it = bid; it < N_HS; it += nb) hgrn_sample_item(p, l, it, lds);
#pragma unroll 1
    for (int it = bid; it < N_SS; it += nb) swa_sample_item(p, l, it, lds);
#pragma unroll 1
    for (int it = bid; it < N_PS; it += nb) pool_sample_item(p, l, it, lds);
    team_barrier(tcnt, (unsigned)(tb * (2 * l + 2)));
#pragma unroll 1
    for (int n = tr; n < 32; n += tb) hgrn_p3_item(p, l, team * 32 + n, lds, false);
#pragma unroll 1
    for (int it = bid; it < N_PP; it += nb) pool_prompt_item(p, l, it, lds);
}

constexpr int LDS_BYTES = 147456;
__global__ void __launch_bounds__(512, 2) fwd_mega(KP p_unused) {
    extern __shared__ __attribute__((aligned(16))) unsigned char lds_raw[];
    LAS unsigned char* lds = (LAS unsigned char*)lds_raw;
    cg::grid_group grid = cg::this_grid();
    KPp p = kargs();
    unsigned char* ws = p->ws;
    const int lo = p->ph_lo, hi = p->ph_hi;
    const int G = gridDim.x, cid = blockIdx.x;
    float* rowss = (float*)(ws + WS_RS);
    bf16* Zb = (bf16*)(ws + WS_Z); bf16* XB = (bf16*)(ws + WS_XB); bf16* BRb = (bf16*)(ws + WS_BR); bf16* GBb = (bf16*)(ws + WS_G);
    float* X = p->out + O_Y;
    if (threadIdx.x < 64) ((LAS unsigned*)(lds + 131072))[threadIdx.x] = 0u;
    __syncthreads();
    if (blockIdx.x == 0) { unsigned* ctl = (unsigned*)(ws + WS_CTL);
        for (int i = threadIdx.x; i < 8192; i += 512) __hip_atomic_store(ctl + i, 0u, __ATOMIC_RELAXED, __HIP_MEMORY_SCOPE_AGENT);
        asm volatile("s_waitcnt vmcnt(0)" ::: "memory"); }
#define IN(k) (lo <= (k) && (k) < hi)
    if (EN(0) && IN(0)) { for (int r_ = 0; r_ < REP_P0; ++r_) { prologue(kargs(), lds); __syncthreads(); } }
    grid.sync();
    XcdBarrier bar = xcd_barrier_post((unsigned*)(ws + WS_CTL), (volatile LAS unsigned*)(lds + 131072) + 8);
#define SEAM(k) do { if (IN(k) && IN((k) + 1)) { for (int r_ = 0; r_ < REP_SYNC; ++r_) { xcd_barrier(bar); } } } while (0)
#pragma unroll 1
    for (int l = 0; l < DEPTH; ++l) {
        const int ph = 1 + 6 * l;
        if (EN(1) && IN(ph)) for (int r_ = 0; r_ < REP_A; ++r_) {
            pg8::Gemm g{XB, (const bf16*)(ws + WS_WIN) + (size_t)l * 6400 * 1024, MT, DIN, 1024}; pg8::StaticOrder S; S.init(MT, DIN, G, cid);
            pg8::EpiScaleBf16<0, true> E{Zb, DIN, rowss + (size_t)(2 * l) * MT * 16};
            pg8::gemm_phase<pg8::EpiScaleBf16<0, true>, pg8::StaticOrder, true, true>(lds, g, S, E);
            { const int nun = NMT * (DIN / 256), rem = nun % G;
                if (r_ == 0) { const int b0 = (rem > 0 && rem < G) ? rem : 0;
                    if (cid >= b0) { wconv_layer(kargs(), l, lds, b0, 1); if (l + 1 < DEPTH) wconv_layer(kargs(), l + 1, lds, b0, 0); } } } }
        SEAM(ph);
        if (EN(2) && IN(ph + 1)) { for (int r_ = 0; r_ < REP_B; ++r_) { mixers(kargs(), l, lds); __syncthreads(); } }
        SEAM(ph + 1);
        if (EN(3) && IN(ph + 2)) for (int r_ = 0; r_ < REP_C; ++r_) {
            pg8::Gemm g{BRb, (const bf16*)(ws + WS_WBR) + (size_t)l * 3 * 1024 * 512, 3 * MT, 3 * 1024, 512}; pg8::BranchOrder S; S.init(MP, MT, G, cid);
            pg8::EpiBranch E{Zb, GBb, NMT};
            pg8::gemm_phase<pg8::EpiBranch, pg8::BranchOrder, true, true>(lds, g, S, E);
            tail_branch(kargs(), l, lds); }
        SEAM(ph + 2);
        if (EN(4) && IN(ph + 3)) for (int r_ = 0; r_ < REP_D; ++r_) {
            pg8::Gemm g{GBb, (const bf16*)(ws + WS_WO) + (size_t)l * 1024 * 1024, MP, 1024, 1024}; pg8::StaticOrder S; S.init(MP, 1024, G, cid);
            pg8::EpiResid E{XB, BRb, nullptr, rowss + (size_t)(2 * l + 1) * MT * 16};
            pg8::gemm_phase<pg8::EpiResid, pg8::StaticOrder, true, true>(lds, g, S, E);
            tail_resid(kargs(), GBb, (const bf16*)(ws + WS_WO) + (size_t)l * 1024 * 1024, 1024, XB, BRb, nullptr, rowss + (size_t)(2 * l + 1) * MT * 16, lds); }
        SEAM(ph + 3);
        if (EN(5) && IN(ph + 4)) for (int r_ = 0; r_ < REP_E; ++r_) {
            pg8::Gemm g{BRb, (const bf16*)(ws + WS_WUP) + (size_t)l * 4096 * 1024, MP, DFF, 1024}; pg8::StaticOrder S; S.init(MP, DFF, G, cid);
            pg8::EpiScaleBf16<1> E{Zb, DFF, rowss + (size_t)(2 * l + 1) * MT * 16};
            pg8::gemm_phase<pg8::EpiScaleBf16<1>, pg8::StaticOrder, true, true>(lds, g, S, E);
            for (int r2_ = 0; r2_ < REP_TU; ++r2_) tail_up(kargs(), l, rowss + (size_t)(2 * l + 1) * MT * 16, lds); }
        SEAM(ph + 4);
        if (EN(6) && IN(ph + 5)) for (int r_ = 0; r_ < REP_F; ++r_) {
            float* Xf = (l == DEPTH - 1) ? X : nullptr;
            pg8::Gemm g{Zb, (const bf16*)(ws + WS_WDN) + (size_t)l * 1024 * 4096, MP, 1024, DFF}; pg8::StaticOrder S; S.init(MP, 1024, G, cid);
            pg8::EpiResid E{BRb, XB, Xf, rowss + (size_t)(2 * l + 2) * MT * 16};
            pg8::gemm_phase<pg8::EpiResid, pg8::StaticOrder, true, true>(lds, g, S, E);
            for (int r2_ = 0; r2_ < REP_TF; ++r2_) tail_resid(kargs(), Zb, (const bf16*)(ws + WS_WDN) + (size_t)l * 1024 * 4096, DFF, BRb, XB, Xf, rowss + (size_t)(2 * l + 2) * MT * 16, lds); }
        SEAM(ph + 5);
    }
#undef IN
#undef SEAM
}

#ifndef MK_LAUNCH_MODE
#define MK_LAUNCH_MODE 0
#endif
extern "C" void kernel_launch(void* const* d_in, const int* in_sizes, int n_in, void* d_out, int out_size, void* d_ws, size_t ws_size, hipStream_t stream) {
    static int grid = 0;
    if (grid == 0) {
        if (n_in != 20 || ws_size < WS_END) { fprintf(stderr, "kernel_launch: unexpected n_in %d or ws_size %zu (< %zu)\n", n_in, ws_size, (size_t)WS_END); grid = -1; return; }
        int dev = 0, cus = 0, per_cu = 0;
        hipGetDevice(&dev); hipDeviceGetAttribute(&cus, hipDeviceAttributeMultiprocessorCount, dev);
        hipFuncSetAttribute((const void*)fwd_mega, hipFuncAttributeMaxDynamicSharedMemorySize, LDS_BYTES);
        if (hipOccupancyMaxActiveBlocksPerMultiprocessor(&per_cu, (const void*)fwd_mega, 512, LDS_BYTES) != hipSuccess || per_cu < 1) per_cu = 1;
        (void)hipGetLastError();
        grid = cus * 1;
        if (grid <= 0) grid = 256;
        grid -= grid % 32;
    }
    if (grid < 0) return;
    KP a{};
    for (int i = 0; i < 20; ++i) a.in[i] = (const float*)d_in[i];
    a.out = (float*)d_out; a.ws = (unsigned char*)d_ws;
#if MK_LAUNCH_MODE == 0
    a.ph_lo = 0; a.ph_hi = 25;
    void* args[] = {&a};
    hipError_t e = hipLaunchCooperativeKernel((const void*)fwd_mega, dim3(grid), dim3(512), args, LDS_BYTES, stream);
    if (e != hipSuccess) fprintf(stderr, "cooperative launch failed: %s (grid %d)\n", hipGetErrorString(e), grid);
#else
    for (int ph = 0; ph < 25; ++ph) { a.ph_lo = ph; a.ph_hi = ph + 1; hipLaunchKernelGGL(fwd_mega, dim3(grid), dim3(512), LDS_BYTES, stream, a); }
#endif
}
```

```cpp
#include <hip/hip_runtime.h>
#include <hip/hip_cooperative_groups.h>
#include <cstdio>
#include <cstdint>
namespace cg = cooperative_groups;
#ifndef ONLY
#define ONLY -1
#endif
#define EN(k) (ONLY < 0 || ONLY == (k))
#ifndef REP_P0
#define REP_P0 1
#endif
#ifndef REP_A
#define REP_A 1
#endif
#ifndef REP_B
#define REP_B 1
#endif
#ifndef REP_C
#define REP_C 1
#endif
#ifndef REP_E
#define REP_E 1
#endif
#ifndef REP_HP
#define REP_HP 1
#endif
#ifndef REP_B1
#define REP_B1 1
#endif
#ifndef REP_B2
#define REP_B2 1
#endif
#ifndef REP_PP
#define REP_PP 1
#endif
#ifndef REP_SP
#define REP_SP 1
#endif
#ifndef REP_HS
#define REP_HS 1
#endif
#ifndef REP_D
#define REP_D 1
#endif
#ifndef REP_F
#define REP_F 1
#endif
#ifndef REP_P1
#define REP_P1 1
#endif
#ifndef REP_P3
#define REP_P3 1
#endif
#ifndef REP_TU
#define REP_TU 1
#endif
#ifndef REP_TF
#define REP_TF 1
#endif
#ifndef REP_SYNC
#define REP_SYNC 1
#endif
#ifndef MIXMASK
#define MIXMASK 63
#endif
#define EN2(k) ((ONLY < 0 || ONLY == 2 || ONLY == (k)) && ((MIXMASK >> ((k) - 20)) & 1))

namespace pg8 {
#define PG8_LAS __attribute__((address_space(3)))
typedef unsigned short bf16_t;
typedef short bf16x8 __attribute__((ext_vector_type(8)));
typedef float f32x4 __attribute__((ext_vector_type(4)));
typedef unsigned u32x4 __attribute__((ext_vector_type(4)));
constexpr int BM = 256, BK = 64, HALF = 128, HTB = HALF * BK * 2  , STAGE_BYTES = 8 * HTB, NXCD = 8, WGM = 8;

__host__ __device__ __forceinline__ int lds_byte(int r, int c) { const int st = (r >> 4) * 2 + (c >> 5), rr = r & 15, cc = c & 31, ob = rr * 64 + cc * 2; return st * 1024 + (ob ^ (((ob >> 9) & 1) << 5)); }
__host__ __device__ __forceinline__ void stage_rc(int b, int& R, int& C) { const int st = b / 1024, sb = b % 1024, swz = sb ^ (((sb >> 9) & 1) << 5); R = (st >> 1) * 16 + swz / 64; C = (st & 1) * 32 + (swz % 64) / 2; }
__host__ __device__ __forceinline__ int perm32(int rho) { const int n = rho >> 4, i = rho & 15; return 8 * (i >> 2) + 4 * n + (i & 3); }

struct Unit { int pm, pn; };
struct Gemm { const bf16_t* A; const bf16_t* Bt; int M, N, K; };

struct StaticOrder {
    int nM, nN, nwg, G, c;
    __host__ __device__ void init(int M, int N, int G_, int c_) { nM = M / BM; nN = N / BM; nwg = nM * nN; G = G_; c = c_; }
    __host__ __device__ bool next(int i, Unit& u) const {
        const long L = (long)i * G + c; if (L >= nwg) return false;
        int wgid = (int)L; { const int q = nwg / NXCD, r = nwg % NXCD, xcd = wgid % NXCD, off = wgid / NXCD; wgid = (xcd < r ? xcd * (q + 1) : r * (q + 1) + (xcd - r) * q) + off; }
        const int nig = WGM * nN, gid = wgid / nig, fm = gid * WGM, gsz = (nM - fm) < WGM ? (nM - fm) : WGM;
        u.pm = fm + ((wgid % nig) % gsz); u.pn = (wgid % nig) / gsz; return true;
    }
    __device__ __forceinline__ void a_ready(const Unit&) const {}
    __device__ __forceinline__ void done(const Unit&) const {}
};

__device__ __forceinline__ unsigned cvt_pk_bf16(float lo, float hi) { unsigned r; asm volatile("v_cvt_pk_bf16_f32 %0, %1, %2" : "=v"(r) : "v"(lo), "v"(hi)); return r; }
template <class Epi, class Sched, bool ALIGN_EPI = false, bool SP2 = false>
__device__ __forceinline__ void gemm_phase(PG8_LAS unsigned char* lds, const Gemm g, const Sched& S, const Epi& E) {
    int tid_o = threadIdx.x; asm volatile("" : "+v"(tid_o));
    const int tid = tid_o, wid = __builtin_amdgcn_readfirstlane(tid >> 6), lane = tid & 63, wr = wid >> 2, wc = wid & 3, fr = lane & 15, fq = lane >> 4;
    const int K = g.K, nt = K / BK;
    unsigned voffA[2], voffB[2];
#pragma unroll
    for (int i = 0; i < 2; ++i) { int R, C; stage_rc(tid * 16 + i * 8192, R, C); const int Rb = Epi::PERM ? ((R & ~31) + perm32(R & 31)) : R;
        voffA[i] = (unsigned)(R * K + C) * 2u; voffB[i] = (unsigned)(Rb * K + C) * 2u; }
    const size_t kstep = (size_t)(BK * 2);
    const size_t hstep = (size_t)HALF * K * 2;
    const size_t tstep = 2 * hstep;
    const unsigned ldsw = (unsigned)wid * 1024u;
    const int aoff = lds_byte(wr * 64 + fr, fq * 8), boff = lds_byte(wc * 32 + fr, fq * 8);
#define PG8_SA(b, h) (((b) * 2 + (h)) * HTB)
#define PG8_SB(b, h) ((4 + (b) * 2 + (h)) * HTB)
#define PG8_STAGE(bufoff, gbase, voff) do { _Pragma("unroll") for (int _i = 0; _i < 2; ++_i) \
        __builtin_amdgcn_global_load_lds((const unsigned*)((const char*)(gbase) + (voff)[_i]), (PG8_LAS unsigned*)(lds + (bufoff) + ldsw + _i * 8192), 16, 0, 0); } while (0)
#define PG8_LDA(dst, b, h) do { _Pragma("unroll") for (int m = 0; m < 4; ++m) _Pragma("unroll") for (int k = 0; k < 2; ++k) dst[m][k] = *(const PG8_LAS bf16x8*)(lds + PG8_SA(b, h) + aoff + m * 2048 + k * 1024); } while (0)
#define PG8_LDB(dst, b, h) do { _Pragma("unroll") for (int n = 0; n < 2; ++n) _Pragma("unroll") for (int k = 0; k < 2; ++k) dst[n][k] = *(const PG8_LAS bf16x8*)(lds + PG8_SB(b, h) + boff + n * 2048 + k * 1024); } while (0)
#define PG8_MMA(ai, bj, At, Bt) do { __builtin_amdgcn_s_setprio(1); _Pragma("unroll") for (int m = 0; m < 4; ++m) _Pragma("unroll") for (int n = 0; n < 2; ++n) _Pragma("unroll") for (int k = 0; k < 2; ++k) \
        acc[ai][bj][m][n] = __builtin_amdgcn_mfma_f32_16x16x32_bf16(Bt[n][k], At[m][k], acc[ai][bj][m][n], 0, 0, 0); __builtin_amdgcn_s_setprio(0); } while (0)
#define PG8_WAIT_V(n) asm volatile("s_waitcnt vmcnt(" #n ")" ::: "memory")
#define PG8_WAIT_L(n) asm volatile("s_waitcnt lgkmcnt(" #n ")" ::: "memory")
#define PG8_BAR __builtin_amdgcn_s_barrier()
#define PG8_SCHED __builtin_amdgcn_sched_barrier(0)
    Unit cur, nxt; int ui = 0;
    if (!S.next(0, cur)) return;
    f32x4 acc[2][2][4][2];
#pragma unroll
    for (int a = 0; a < 2; ++a)
#pragma unroll
        for (int b = 0; b < 2; ++b)
#pragma unroll
            for (int m = 0; m < 4; ++m)
#pragma unroll
                for (int n = 0; n < 2; ++n) acc[a][b][m][n] = (f32x4){0.f, 0.f, 0.f, 0.f};
    bf16x8 At[4][2], B0[2][2], B1[2][2];
    const char* cA = (const char*)g.A + (size_t)cur.pm * tstep; const char* cB = (const char*)g.Bt + (size_t)cur.pn * tstep;
    S.a_ready(cur);
    if constexpr (SP2) {
        PG8_STAGE(PG8_SB(0, 0), cB, voffB); PG8_STAGE(PG8_SB(0, 1), cB + hstep, voffB); PG8_STAGE(PG8_SA(0, 0), cA, voffA); PG8_STAGE(PG8_SA(0, 1), cA + hstep, voffA);
        if (wr == 1) PG8_BAR;
        PG8_WAIT_V(2); PG8_BAR;
        PG8_STAGE(PG8_SB(1, 0), cB + kstep, voffB); PG8_STAGE(PG8_SA(1, 0), cA + kstep, voffA); PG8_STAGE(PG8_SB(1, 1), cB + hstep + kstep, voffB);
        PG8_WAIT_V(6); PG8_BAR;
    } else {
        PG8_STAGE(PG8_SB(0, 0), cB, voffB); PG8_STAGE(PG8_SA(0, 0), cA, voffA); PG8_STAGE(PG8_SB(0, 1), cB + hstep, voffB); PG8_STAGE(PG8_SA(0, 1), cA + hstep, voffA);
        if (wr == 1) PG8_BAR;
        PG8_WAIT_V(4); PG8_BAR;
        PG8_STAGE(PG8_SB(1, 0), cB + kstep, voffB); PG8_STAGE(PG8_SA(1, 0), cA + kstep, voffA); PG8_STAGE(PG8_SB(1, 1), cB + hstep + kstep, voffB);
        PG8_WAIT_V(6); PG8_BAR;
    }
    for (;;) {
        const bool has_next = S.next(ui + 1, nxt);
        const char* nA = has_next ? (const char*)g.A + (size_t)nxt.pm * tstep : cA; const char* nB = has_next ? (const char*)g.Bt + (size_t)nxt.pn * tstep : cB;
        for (int t = 0; t < nt; t += 2) {
            const bool last = (t == nt - 2);
            const char* a1 = cA + (size_t)(t + 1) * kstep;
            const char* a2 = last ? nA : cA + (size_t)(t + 2) * kstep; const char* b2 = last ? nB : cB + (size_t)(t + 2) * kstep;
            const char* a3 = a2 + kstep; const char* b3 = b2 + kstep;
            if (last && has_next) S.a_ready(nxt);
            if constexpr (SP2) {
            PG8_LDB(B0, 0, 0); PG8_LDB(B1, 0, 1); PG8_SCHED; PG8_LDA(At, 0, 0); PG8_STAGE(PG8_SA(1, 1), a1 + hstep, voffA);
            PG8_WAIT_V(8); PG8_WAIT_L(0); PG8_BAR; PG8_MMA(0, 0, At, B0); PG8_MMA(0, 1, At, B1); PG8_BAR; PG8_SCHED;
            PG8_LDA(At, 0, 1); PG8_STAGE(PG8_SB(0, 0), b2, voffB); PG8_STAGE(PG8_SB(0, 1), b2 + hstep, voffB); PG8_STAGE(PG8_SA(0, 0), a2, voffA);
            PG8_WAIT_V(8); PG8_WAIT_L(0); PG8_BAR; PG8_MMA(1, 0, At, B0); PG8_MMA(1, 1, At, B1); PG8_BAR; PG8_SCHED;
            PG8_LDB(B0, 1, 0); PG8_LDB(B1, 1, 1); PG8_SCHED; PG8_LDA(At, 1, 0); PG8_STAGE(PG8_SA(0, 1), a2 + hstep, voffA);
            PG8_WAIT_V(8); PG8_WAIT_L(0); PG8_BAR; PG8_MMA(0, 0, At, B0); PG8_MMA(0, 1, At, B1); PG8_BAR; PG8_SCHED;
            PG8_LDA(At, 1, 1); PG8_STAGE(PG8_SB(1, 0), b3, voffB); PG8_STAGE(PG8_SB(1, 1), b3 + hstep, voffB); PG8_STAGE(PG8_SA(1, 0), a3, voffA);
            PG8_WAIT_V(8); PG8_WAIT_L(0); PG8_BAR; PG8_MMA(1, 0, At, B0); PG8_MMA(1, 1, At, B1); PG8_BAR; PG8_SCHED;
            } else {
            PG8_LDB(B0, 0, 0); PG8_SCHED; PG8_LDA(At, 0, 0); PG8_STAGE(PG8_SA(1, 1), a1 + hstep, voffA);
            PG8_WAIT_L(8); PG8_BAR; PG8_WAIT_L(0); PG8_MMA(0, 0, At, B0); PG8_BAR; PG8_SCHED;
            PG8_LDB(B1, 0, 1); PG8_STAGE(PG8_SB(0, 0), b2, voffB);
            PG8_BAR; PG8_WAIT_L(0); PG8_MMA(0, 1, At, B1); PG8_BAR;
            PG8_LDA(At, 0, 1); PG8_STAGE(PG8_SA(0, 0), a2, voffA);
            PG8_BAR; PG8_WAIT_L(0); PG8_MMA(1, 0, At, B0); PG8_BAR; PG8_SCHED;
            PG8_STAGE(PG8_SB(0, 1), b2 + hstep, voffB);
            PG8_WAIT_V(6); PG8_BAR; PG8_MMA(1, 1, At, B1); PG8_BAR;
            PG8_LDB(B0, 1, 0); PG8_SCHED; PG8_LDA(At, 1, 0); PG8_STAGE(PG8_SA(0, 1), a2 + hstep, voffA);
            PG8_WAIT_L(8); PG8_BAR; PG8_WAIT_L(0); PG8_MMA(0, 0, At, B0); PG8_BAR; PG8_SCHED;
            PG8_LDB(B1, 1, 1); PG8_STAGE(PG8_SB(1, 0), b3, voffB);
            PG8_BAR; PG8_WAIT_L(0); PG8_MMA(0, 1, At, B1); PG8_BAR;
            PG8_LDA(At, 1, 1); PG8_STAGE(PG8_SA(1, 0), a3, voffA);
            PG8_BAR; PG8_WAIT_L(0); PG8_MMA(1, 0, At, B0); PG8_BAR; PG8_SCHED;
            PG8_STAGE(PG8_SB(1, 1), b3 + hstep, voffB);
            PG8_WAIT_V(6); PG8_BAR; PG8_MMA(1, 1, At, B1); PG8_BAR;
            }
        }
        if constexpr (ALIGN_EPI) { if (wr == 0) PG8_BAR; }
        if constexpr (!Epi::AFTER_DRAIN) { E(acc, cur, wr, wc, fr, fq); S.done(cur); }
        if (!has_next) break;
#pragma unroll
        for (int a = 0; a < 2; ++a)
#pragma unroll
            for (int b = 0; b < 2; ++b)
#pragma unroll
                for (int m = 0; m < 4; ++m)
#pragma unroll
                    for (int n = 0; n < 2; ++n) acc[a][b][m][n] = (f32x4){0.f, 0.f, 0.f, 0.f};
        cur = nxt; cA = nA; cB = nB; ++ui;
        if constexpr (ALIGN_EPI) { if (wr == 1) PG8_BAR; }
    }
    PG8_WAIT_V(0);
    if constexpr (!ALIGN_EPI) { if (wr == 0) PG8_BAR; }
    PG8_BAR;
    if constexpr (Epi::AFTER_DRAIN) { E.fused(acc, cur, wr, wc, fr, fq, lds, wid, lane); S.done(cur); }
#undef PG8_SA
#undef PG8_SB
#undef PG8_STAGE
#undef PG8_LDA
#undef PG8_LDB
#undef PG8_MMA
#undef PG8_WAIT_V
#undef PG8_WAIT_L
#undef PG8_BAR
#undef PG8_SCHED
}
__device__ __forceinline__ float bf2f_(unsigned short h) { return __uint_as_float((unsigned)h << 16); }
__device__ __forceinline__ size_t gate_slot_off(int T, int i, int tid) { const unsigned q = (unsigned)((T * 16 + i) * 512 + tid); return (size_t)(q / 384u) * 6400 + 3328 + (size_t)(q % 384u) * 8; }
template <int ACT  , bool GATES = false> struct EpiScaleBf16 {
    static constexpr bool PERM = true, AFTER_DRAIN = false;
    bf16_t* O; int ldc; const float* rowss;
    __device__ __forceinline__ void operator()(const f32x4 (&acc)[2][2][4][2], const Unit& u, int wr, int wc, int fr, int fq) const {
        const int row0 = u.pm * BM + wr * 64 + fr, col0 = u.pn * BM + wc * 32 + 8 * fq;
        const bool gt = GATES && u.pn >= 13 && u.pm < 64; const int T = u.pm * 12 + (u.pn - 13), tid = (wr * 4 + wc) * 64 + fq * 16 + fr;
#pragma unroll
        for (int ai = 0; ai < 2; ++ai)
#pragma unroll
            for (int m = 0; m < 4; ++m) { const int row = row0 + ai * HALF + m * 16; const f32x4 r0 = *(const f32x4*)(rowss + (size_t)row * 16), r1 = *(const f32x4*)(rowss + (size_t)row * 16 + 4), r2 = *(const f32x4*)(rowss + (size_t)row * 16 + 8), r3 = *(const f32x4*)(rowss + (size_t)row * 16 + 12);
                const float rsum = (((r0[0] + r0[1]) + (r0[2] + r0[3])) + ((r1[0] + r1[1]) + (r1[2] + r1[3]))) + (((r2[0] + r2[1]) + (r2[2] + r2[3])) + ((r3[0] + r3[1]) + (r3[2] + r3[3])));
                const float rs = rsqrtf(rsum * (1.0f / 1024.0f) + 1e-6f);
                bf16_t* rowp = O + (size_t)row * ldc + col0;
#pragma unroll
                for (int bj = 0; bj < 2; ++bj) { f32x4 v0 = acc[ai][bj][m][0] * rs, v1 = acc[ai][bj][m][1] * rs;
                    if (ACT == 1) {
#pragma unroll
                        for (int j = 0; j < 4; ++j) { const float a = fmaxf(v0[j], 0.f), b = fmaxf(v1[j], 0.f); v0[j] = a * a; v1[j] = b * b; } }
                    u32x4 w; w.x = cvt_pk_bf16(v0[0], v0[1]); w.y = cvt_pk_bf16(v0[2], v0[3]); w.z = cvt_pk_bf16(v1[0], v1[1]); w.w = cvt_pk_bf16(v1[2], v1[3]);
                    if (gt) *(u32x4*)(O + gate_slot_off(T, (ai * 4 + m) * 2 + bj, tid)) = w;
                    else *(u32x4*)(rowp + bj * HALF) = w; } }
    }
};
struct EpiBranch {
    static constexpr bool PERM = true, AFTER_DRAIN = false;
    const bf16_t* Z; bf16_t* gb; int nmt;
    __device__ __forceinline__ void operator()(const f32x4 (&acc)[2][2][4][2], const Unit& u, int wr, int wc, int fr, int fq) const {
        const int br = u.pm / nmt, pm = u.pm - br * nmt, pn = u.pn - br * 4;
        const int row0 = pm * BM + wr * 64 + fr, col0 = pn * BM + wc * 32 + 8 * fq;
        bf16_t* gp0 = gb + (size_t)row0 * 1024 + col0; const int T = pm * 12 + br * 4 + pn, tid = (wr * 4 + wc) * 64 + fq * 16 + fr;
#pragma unroll
        for (int ai = 0; ai < 2; ++ai)
#pragma unroll
            for (int mh = 0; mh < 4; ++mh) {
                u32x4 gz[2], pz[2];
#pragma unroll
                for (int i = 0; i < 2; ++i) { const int m = mh, bj = i; const size_t ro = (size_t)(ai * HALF + m * 16);
                    gz[i] = *(const u32x4*)(Z + gate_slot_off(T, (ai * 4 + m) * 2 + bj, tid));
                    if (br != 0) pz[i] = *(const u32x4*)(gp0 + ro * 1024 + bj * HALF); }
                asm volatile("" ::: "memory");
#pragma unroll
                for (int i = 0; i < 2; ++i) { const int m = mh, bj = i; const size_t ro = (size_t)(ai * HALF + m * 16);
                    f32x4 g0, g1;
                    g0[0] = __uint_as_float(gz[i].x << 16); g0[1] = __uint_as_float(gz[i].x & 0xffff0000u); g0[2] = __uint_as_float(gz[i].y << 16); g0[3] = __uint_as_float(gz[i].y & 0xffff0000u);
                    g1[0] = __uint_as_float(gz[i].z << 16); g1[1] = __uint_as_float(gz[i].z & 0xffff0000u); g1[2] = __uint_as_float(gz[i].w << 16); g1[3] = __uint_as_float(gz[i].w & 0xffff0000u);
#pragma unroll
                    for (int j = 0; j < 4; ++j) { g0[j] = __builtin_amdgcn_rcpf(1.f + __builtin_amdgcn_exp2f(g0[j] * -1.4426950408889634f)); g1[j] = __builtin_amdgcn_rcpf(1.f + __builtin_amdgcn_exp2f(g1[j] * -1.4426950408889634f)); }
                    f32x4 v0 = acc[ai][bj][m][0] * g0, v1 = acc[ai][bj][m][1] * g1;
                    if (br != 0) {
                        v0[0] += __uint_as_float(pz[i].x << 16); v0[1] += __uint_as_float(pz[i].x & 0xffff0000u); v0[2] += __uint_as_float(pz[i].y << 16); v0[3] += __uint_as_float(pz[i].y & 0xffff0000u);
                        v1[0] += __uint_as_float(pz[i].z << 16); v1[1] += __uint_as_float(pz[i].z & 0xffff0000u); v1[2] += __uint_as_float(pz[i].w << 16); v1[3] += __uint_as_float(pz[i].w & 0xffff0000u); }
                    u32x4 w; w.x = cvt_pk_bf16(v0[0], v0[1]); w.y = cvt_pk_bf16(v0[2], v0[3]); w.z = cvt_pk_bf16(v1[0], v1[1]); w.w = cvt_pk_bf16(v1[2], v1[3]);
                    *(u32x4*)(gp0 + ro * 1024 + bj * HALF) = w; }
            }
    }
};
struct EpiResid {
    static constexpr bool PERM = true, AFTER_DRAIN = false;
    const bf16_t* res; bf16_t* xo; float* Xf; float* rowss;
    __device__ __forceinline__ void operator()(const f32x4 (&acc)[2][2][4][2], const Unit& u, int wr, int wc, int fr, int fq) const {
        const int row0 = u.pm * BM + wr * 64 + fr, col0 = u.pn * BM + wc * 32 + 8 * fq;
#pragma unroll
        for (int ai = 0; ai < 2; ++ai)
#pragma unroll
            for (int m = 0; m < 4; ++m) { const int row = row0 + ai * HALF + m * 16; float ss = 0.f;
#pragma unroll
                for (int bj = 0; bj < 2; ++bj) { const int c = col0 + bj * HALF;
                    const u32x4 rz = *(const u32x4*)(res + (size_t)row * 1024 + c);
                    f32x4 v0 = acc[ai][bj][m][0], v1 = acc[ai][bj][m][1];
                    v0[0] += __uint_as_float(rz.x << 16); v0[1] += __uint_as_float(rz.x & 0xffff0000u); v0[2] += __uint_as_float(rz.y << 16); v0[3] += __uint_as_float(rz.y & 0xffff0000u);
                    v1[0] += __uint_as_float(rz.z << 16); v1[1] += __uint_as_float(rz.z & 0xffff0000u); v1[2] += __uint_as_float(rz.w << 16); v1[3] += __uint_as_float(rz.w & 0xffff0000u);
                    if (Xf) { float* xp = Xf + (size_t)row * 1024 + c; *(f32x4*)xp = v0; *(f32x4*)(xp + 4) = v1; }
                    u32x4 w; w.x = cvt_pk_bf16(v0[0], v0[1]); w.y = cvt_pk_bf16(v0[2], v0[3]); w.z = cvt_pk_bf16(v1[0], v1[1]); w.w = cvt_pk_bf16(v1[2], v1[3]);
                    *(u32x4*)(xo + (size_t)row * 1024 + c) = w;
                    ss += (v0[0] * v0[0] + v0[1] * v0[1]) + (v0[2] * v0[2] + v0[3] * v0[3]) + (v1[0] * v1[0] + v1[1] * v1[1]) + (v1[2] * v1[2] + v1[3] * v1[3]); }
                ss += __shfl_xor(ss, 16); ss += __shfl_xor(ss, 32);
                if (fq == 0) rowss[(size_t)row * 16 + u.pn * 4 + wc] = ss; }
    }
};
struct BranchOrder {
    StaticOrder base; int nmt;
    __device__ void init(int Mtiles_rows, int Mpitch_rows, int G_, int c_) { base.init(Mtiles_rows, 1024, G_, c_); nmt = Mpitch_rows / BM; }
    __device__ bool next(int i, Unit& u) const { const int ti = i / 3, br = i - 3 * ti; Unit t; if (!base.next(ti, t)) return false; u.pm = br * nmt + t.pm; u.pn = br * 4 + t.pn; return true; }
    __device__ __forceinline__ void a_ready(const Unit&) const {}
    __device__ __forceinline__ void done(const Unit&) const {}
};
}

#define LAS __attribute__((address_space(3)))
typedef unsigned short bf16;
typedef short bf16x8 __attribute__((ext_vector_type(8)));
typedef float f32x4 __attribute__((ext_vector_type(4)));
typedef unsigned u32x4 __attribute__((ext_vector_type(4)));
typedef unsigned u32x2 __attribute__((ext_vector_type(2)));

constexpr int DMODEL = 1024, NB = 8, SEQ = 2048, DEPTH = 4, DECB = 128, DECT = 4, PAST = 8192;
constexpr int MP = NB * SEQ, MS = DECB * DECT, MT = MP + MS;
constexpr int DIN = 6400, DFF = 4096, NMT = MT / 256;
constexpr int C_ZQ = 0, C_ZK = 512, C_ZV = 640, C_HQ = 768, C_HF = 1280, C_HI = 1792, C_HG = 2304, C_U = 2816, C_ZG = 3328;
constexpr float LOG2E = 1.4426950408889634f;
constexpr size_t O_Y = 0, O_SHP = (size_t)MT * 1024, O_CKP = O_SHP + (size_t)4 * 8 * 4 * 128 * 128, O_CVP = O_CKP + (size_t)4 * 8 * 128 * 128,
                 O_SPP = O_CVP + (size_t)4 * 8 * 128 * 128, O_SHS = O_SPP + (size_t)4 * 8 * 15 * 512, O_CKS = O_SHS + (size_t)4 * 128 * 4 * 128 * 128,
                 O_CVS = O_CKS + (size_t)4 * 128 * 128 * 128, O_SPS = O_CVS + (size_t)4 * 128 * 128 * 128;
constexpr size_t WS_CTL = 0, CTL_BYTES = 1u << 20;
constexpr size_t WS_WIN = WS_CTL + CTL_BYTES;
constexpr size_t WS_WBR = WS_WIN + (size_t)4 * 6400 * 1024 * 2;
constexpr size_t WS_WO = WS_WBR + (size_t)4 * 3 * 1024 * 512 * 2;
constexpr size_t WS_WUP = WS_WO + (size_t)4 * 1024 * 1024 * 2;
constexpr size_t WS_WDN = WS_WUP + (size_t)4 * 4096 * 1024 * 2;
constexpr size_t WS_WPL = WS_WDN + (size_t)4 * 4096 * 1024 * 2;
constexpr size_t WS_Z = WS_WPL + (size_t)4 * 4 * 128 * 128 * 2;
constexpr size_t WS_XB = WS_Z + (size_t)MT * 6400 * 2;
constexpr size_t WS_BR = WS_XB + (size_t)MT * 1024 * 2;
constexpr size_t WS_G = WS_BR + (size_t)3 * MT * 512 * 2;
constexpr size_t WS_SST_OFF = (size_t)1024 * 16384 * 2;
constexpr size_t WS_RS = WS_G + (size_t)MT * 1024 * 4;
constexpr size_t WS_OI = WS_RS + (size_t)9 * MT * 16 * 4;
constexpr size_t WS_DV = WS_OI + (size_t)1024 * 8192 * 2;
constexpr size_t WS_END = WS_DV + (size_t)1024 * 128 * 4;

struct KP { const float* in[20]; float* out; unsigned char* ws; int ph_lo, ph_hi; };
typedef const __attribute__((address_space(4))) KP* KPp;
__device__ __forceinline__ KPp kargs() { KPp q = (KPp)__builtin_amdgcn_kernarg_segment_ptr(); asm volatile("" : "+s"(q)); return q; }

__device__ __forceinline__ float bf2f(unsigned short h) { return __uint_as_float((unsigned)h << 16); }
__device__ __forceinline__ unsigned pk2(float lo, float hi) { return pg8::cvt_pk_bf16(lo, hi); }
__device__ __forceinline__ unsigned short f2bf(float f) { return (unsigned short)(pk2(f, 0.f) & 0xffffu); }
__device__ __forceinline__ int opq_tid() { int t = threadIdx.x; asm volatile("" : "+v"(t)); return t; }
__device__ __forceinline__ float sigm(float x) { return __builtin_amdgcn_rcpf(1.f + __expf(-x)); }
__device__ __forceinline__ f32x4 mfma16(bf16x8 a, bf16x8 b, f32x4 c) { return __builtin_amdgcn_mfma_f32_16x16x32_bf16(a, b, c, 0, 0, 0); }
__device__ __forceinline__ bf16x8 pack8(const float (&y)[8]) { u32x4 w; w.x = pk2(y[0], y[1]); w.y = pk2(y[2], y[3]); w.z = pk2(y[4], y[5]); w.w = pk2(y[6], y[7]); return __builtin_bit_cast(bf16x8, w); }
#define LDS_WAIT() asm volatile("s_waitcnt lgkmcnt(0)" ::: "memory")
#define LBAR() asm volatile("s_waitcnt lgkmcnt(0)\n\ts_barrier" ::: "memory")

__device__ __forceinline__ void p0_transpose_item(const float* W, int K, int N, bf16* WT, const float* ksc, LAS bf16* T, int item, int lane) {
    const int nblk = N / 64, kb = item / nblk, nb = item - kb * nblk, k0 = 64 * kb, n0 = 64 * nb, r4 = lane >> 4, c4 = lane & 15;
    f32x4 v[16];
#pragma unroll
    for (int i = 0; i < 16; ++i) v[i] = *(const f32x4*)(W + (size_t)(k0 + 4 * i + r4) * N + n0 + 4 * c4);
    if (ksc) {
#pragma unroll
        for (int i = 0; i < 16; ++i) v[i] = v[i] * ksc[k0 + 4 * i + r4]; }
#pragma unroll
    for (int i = 0; i < 16; ++i) { const unsigned w0 = pk2(v[i][0], v[i][1]), w1 = pk2(v[i][2], v[i][3]); const int kk = 4 * i + r4;
        T[(4 * c4 + 0) * 72 + kk] = (bf16)(w0 & 0xffffu); T[(4 * c4 + 1) * 72 + kk] = (bf16)(w0 >> 16); T[(4 * c4 + 2) * 72 + kk] = (bf16)(w1 & 0xffffu); T[(4 * c4 + 3) * 72 + kk] = (bf16)(w1 >> 16); }
    LDS_WAIT(); asm volatile("" ::: "memory");
#pragma unroll
    for (int j = 0; j < 8; ++j) { const int n = (lane >> 3) + 8 * j, c = lane & 7;
        *(u32x4*)(WT + (size_t)(n0 + n) * K + k0 + 8 * c) = *(const LAS u32x4*)(T + n * 72 + 8 * c); }
    LDS_WAIT(); asm volatile("" ::: "memory");
}
__device__ __forceinline__ void wconv_layer(KPp p, int l, LAS unsigned char* lds, int blk0, int part) {
    const int tid = opq_tid(), lane = tid & 63, wave = tid >> 6;
    LAS bf16* scr = (LAS bf16*)(lds + wave * 16384);
    const int gw = ((int)blockIdx.x - blk0) * 8 + wave, NGW = ((int)gridDim.x - blk0) * 8;
    constexpr int I_IN = 16 * 100, I_BR = 8 * 16, I_O = 16 * 16, I_UP = 16 * 64, I_DN = 64 * 16, I_PL = 2 * 2;
    constexpr int P0N = I_IN + 4 * I_PL, PER_L = P0N + 3 * I_BR + I_O + I_UP + I_DN;
    unsigned char* ws = p->ws;
    const int r_lo = part == 0 ? 0 : P0N, r_hi = part == 0 ? P0N : PER_L;
#pragma unroll 1
    for (int it = r_lo + gw; it < r_hi; it += NGW) {
        int r = it;
        if (r < I_IN) { p0_transpose_item(p->in[7] + (size_t)l * 1024 * 6400, 1024, 6400, (bf16*)(ws + WS_WIN) + (size_t)l * 6400 * 1024, p->in[6] + l * 1024, scr, r, lane); continue; } r -= I_IN;
        if (r < 4 * I_PL) { const int g = r / I_PL; r -= g * I_PL; p0_transpose_item(p->in[13] + (size_t)(l * 4 + g) * 128 * 128, 128, 128, (bf16*)(ws + WS_WPL) + (size_t)(l * 4 + g) * 128 * 128, nullptr, scr, r, lane); continue; } r -= 4 * I_PL;
        if (r < 3 * I_BR) { const int n = r / I_BR; r -= n * I_BR; p0_transpose_item(p->in[15] + (size_t)(l * 3 + n) * 512 * 1024, 512, 1024, (bf16*)(ws + WS_WBR) + (size_t)(l * 3 + n) * 1024 * 512, nullptr, scr, r, lane); continue; } r -= 3 * I_BR;
        if (r < I_O) { p0_transpose_item(p->in[16] + (size_t)l * 1024 * 1024, 1024, 1024, (bf16*)(ws + WS_WO) + (size_t)l * 1024 * 1024, nullptr, scr, r, lane); continue; } r -= I_O;
        if (r < I_UP) { p0_transpose_item(p->in[18] + (size_t)l * 1024 * 4096, 1024, 4096, (bf16*)(ws + WS_WUP) + (size_t)l * 4096 * 1024, p->in[17] + l * 1024, scr, r, lane); continue; } r -= I_UP;
        p0_transpose_item(p->in[19] + (size_t)l * 4096 * 1024, 4096, 1024, (bf16*)(ws + WS_WDN) + (size_t)l * 1024 * 4096, nullptr, scr, r, lane);
    }
}
__device__ __forceinline__ void prologue(KPp p, LAS unsigned char* lds) {
    wconv_layer(p, 0, lds, 0, 0);
    const int lane = threadIdx.x & 63, wave = threadIdx.x >> 6;
    const int gw = blockIdx.x * 8 + wave, NGW = gridDim.x * 8;
    unsigned char* ws = p->ws;
    bf16* xb = (bf16*)(ws + WS_XB); float* rowss = (float*)(ws + WS_RS);
    for (int m = gw; m < MT; m += NGW) {
        const float* src = (m < MP) ? p->in[0] + (size_t)m * 1024 : p->in[1] + (size_t)(m - MP) * 1024;
        float ss = 0.f;
#pragma unroll
        for (int j = 0; j < 4; ++j) { const f32x4 v = *((const f32x4*)src + lane + 64 * j);
            u32x2 w; w.x = pk2(v[0], v[1]); w.y = pk2(v[2], v[3]); *((u32x2*)(xb + (size_t)m * 1024) + lane + 64 * j) = w;
            ss += (v[0] * v[0] + v[1] * v[1]) + (v[2] * v[2] + v[3] * v[3]); }
#pragma unroll
        for (int o = 1; o < 64; o <<= 1) ss += __shfl_xor(ss, o);
        if (lane < 16) rowss[(size_t)m * 16 + lane] = (lane == 0) ? ss : 0.f;
    }
}

__device__ __forceinline__ void rope_cs(float pos, int i, float& c, float& s) {
    const float invr = __builtin_amdgcn_exp2f(-(float)i * 0.41524101186092029f) * 0.15915494309189535f;
    const float pr = pos * invr, er = fmaf(pos, invr, -pr), r = (pr - rintf(pr)) + er;
    s = __builtin_amdgcn_sinf(r); c = __builtin_amdgcn_cosf(r);
}
__device__ __forceinline__ void rope_tab8(float pos, int sq, float (&c)[8], float (&s)[8]) {
#pragma unroll
    for (int e = 0; e < 8; ++e) rope_cs(pos, 8 * sq + e, c[e], s[e]);
}
__device__ __forceinline__ void norm_rope8t(float (&y1)[8], float (&y2)[8], float ss, const float* w, int sq, const float (&c)[8], const float (&s)[8], float oscale) {
    const float rs = rsqrtf(ss * (1.f / 64.f) + 1e-6f);
#pragma unroll
    for (int e = 0; e < 8; ++e) { const float a = y1[e] * rs * w[8 * sq + e], b = y2[e] * rs * w[32 + 8 * sq + e];
        y1[e] = (a * c[e] - b * s[e]) * oscale; y2[e] = (b * c[e] + a * s[e]) * oscale; }
}
__device__ __forceinline__ void norm_rope8(float (&y1)[8], float (&y2)[8], float ss, const float* w, int sq, float pos, float oscale) {
    float c[8], s[8]; rope_tab8(pos, sq, c, s); norm_rope8t(y1, y2, ss, w, sq, c, s, oscale);
}
__device__ __forceinline__ float unpack8(const bf16x8 v, float (&y)[8]) { float ss = 0.f;
#pragma unroll
    for (int e = 0; e < 8; ++e) { y[e] = bf2f((unsigned short)v[e]); ss += y[e] * y[e]; } return ss; }

template <int NKT, int VP, bool UNI>
__device__ __forceinline__ void attn_core(const LAS bf16* Ks, const LAS bf16* Vt, int kt0, bf16x8 q0, bf16x8 q1, int lo, int hi, int minkey, float sink2, f32x4 (&o)[4], float& inv_denom) {
    const int lane = opq_tid() & 63, l16 = lane & 15, q4 = lane >> 4;
    f32x4 acc[NKT];
    { bf16x8 kf[NKT][2];
#pragma unroll
        for (int mt = 0; mt < NKT; ++mt) { const LAS bf16* kp = Ks + (16 * (kt0 + mt) + l16) * 72 + 8 * q4; kf[mt][0] = *(const LAS bf16x8*)kp; kf[mt][1] = *(const LAS bf16x8*)(kp + 32); }
        asm volatile("" ::: "memory");
#pragma unroll
        for (int mt = 0; mt < NKT; ++mt) { acc[mt] = mfma16(kf[mt][0], q0, (f32x4){0.f, 0.f, 0.f, 0.f}); acc[mt] = mfma16(kf[mt][1], q1, acc[mt]); } }
    float mx = sink2;
    const int lo_max = lo + (15 - l16), lo_min = lo - l16;
    const int hi_min = hi - l16;
#pragma unroll
    for (int mt = 0; mt < NKT; ++mt) { const int k0 = 16 * (kt0 + mt);
        const bool whole_l = (k0 > lo_max) && (k0 + 15 <= hi_min) && (k0 >= minkey);
        const bool whole = UNI ? (__builtin_amdgcn_readfirstlane((int)whole_l) != 0) : whole_l;
        if (whole) {
#pragma unroll
            for (int j = 0; j < 4; ++j) mx = fmaxf(mx, acc[mt][j]);
        } else {
#pragma unroll
            for (int j = 0; j < 4; ++j) { const int jj = k0 + 4 * q4 + j; const bool v = (jj > lo) && (jj <= hi) && (jj >= minkey); const float sv = v ? acc[mt][j] : -1e30f; acc[mt][j] = sv; mx = fmaxf(mx, sv); } } }
    mx = fmaxf(mx, __shfl_xor(mx, 16)); mx = fmaxf(mx, __shfl_xor(mx, 32));
    float sum = 0.f;
#pragma unroll
    for (int mt = 0; mt < NKT; ++mt)
#pragma unroll
        for (int j = 0; j < 4; ++j) { const float e = __builtin_amdgcn_exp2f(fmaxf(acc[mt][j] - mx, -126.f)); acc[mt][j] = e; sum += e; }
    sum += __shfl_xor(sum, 16); sum += __shfl_xor(sum, 32);
    inv_denom = 1.f / (sum + __builtin_amdgcn_exp2f(fmaxf(sink2 - mx, -126.f)));
#pragma unroll
    for (int dt = 0; dt < 4; ++dt) o[dt] = (f32x4){0.f, 0.f, 0.f, 0.f};
#pragma unroll
    for (int pp = 0; pp < NKT / 2; ++pp) {
        u32x4 pw; pw.x = pk2(acc[2 * pp][0], acc[2 * pp][1]); pw.y = pk2(acc[2 * pp][2], acc[2 * pp][3]); pw.z = pk2(acc[2 * pp + 1][0], acc[2 * pp + 1][1]); pw.w = pk2(acc[2 * pp + 1][2], acc[2 * pp + 1][3]);
        const bf16x8 pb = __builtin_bit_cast(bf16x8, pw);
        u32x4 aw[4];
#pragma unroll
        for (int dt = 0; dt < 4; ++dt) { const LAS bf16* vp = Vt + (16 * dt + l16) * VP + 16 * kt0 + 32 * pp + 4 * q4;
            const u32x2 a0 = *(const LAS u32x2*)vp, a1 = *(const LAS u32x2*)(vp + 16);
            aw[dt].x = a0.x; aw[dt].y = a0.y; aw[dt].z = a1.x; aw[dt].w = a1.y; }
        asm volatile("" ::: "memory");
#pragma unroll
        for (int dt = 0; dt < 4; ++dt) o[dt] = mfma16(__builtin_bit_cast(bf16x8, aw[dt]), pb, o[dt]);
    }
}

template <int NKT, int VP>
__device__ __forceinline__ void attn_core2(const LAS bf16* Ks, const LAS bf16* Vt, int kt0, const bf16x8 (&qf)[2][2], int lo, int hi, int minkey, const float (&sink2)[2], f32x4 (&o)[2][4], float (&inv_denom)[2]) {
    const int lane = opq_tid() & 63, l16 = lane & 15, q4 = lane >> 4;
    f32x4 acc[2][NKT];
    { bf16x8 kf[NKT][2];
#pragma unroll
        for (int mt = 0; mt < NKT; ++mt) { const LAS bf16* kp = Ks + (16 * (kt0 + mt) + l16) * 72 + 8 * q4; kf[mt][0] = *(const LAS bf16x8*)kp; kf[mt][1] = *(const LAS bf16x8*)(kp + 32); }
        asm volatile("" ::: "memory");
#pragma unroll
        for (int mt = 0; mt < NKT; ++mt)
#pragma unroll
            for (int hh = 0; hh < 2; ++hh) { acc[hh][mt] = mfma16(kf[mt][0], qf[hh][0], (f32x4){0.f, 0.f, 0.f, 0.f}); acc[hh][mt] = mfma16(kf[mt][1], qf[hh][1], acc[hh][mt]); } }
    float mx[2] = {sink2[0], sink2[1]};
    const int lo_max = lo + (15 - l16), hi_min = hi - l16;
#pragma unroll
    for (int mt = 0; mt < NKT; ++mt) { const int k0 = 16 * (kt0 + mt);
        const bool whole = __builtin_amdgcn_readfirstlane((int)((k0 > lo_max) && (k0 + 15 <= hi_min) && (k0 >= minkey))) != 0;
        if (whole) {
#pragma unroll
            for (int j = 0; j < 4; ++j) { mx[0] = fmaxf(mx[0], acc[0][mt][j]); mx[1] = fmaxf(mx[1], acc[1][mt][j]); }
        } else {
#pragma unroll
            for (int j = 0; j < 4; ++j) { const int jj = k0 + 4 * q4 + j; const bool v = (jj > lo) && (jj <= hi) && (jj >= minkey);
                const float s0 = v ? acc[0][mt][j] : -1e30f, s1 = v ? acc[1][mt][j] : -1e30f; acc[0][mt][j] = s0; acc[1][mt][j] = s1; mx[0] = fmaxf(mx[0], s0); mx[1] = fmaxf(mx[1], s1); } } }
#pragma unroll
    for (int hh = 0; hh < 2; ++hh) { mx[hh] = fmaxf(mx[hh], __shfl_xor(mx[hh], 16)); mx[hh] = fmaxf(mx[hh], __shfl_xor(mx[hh], 32)); }
    float sum[2] = {0.f, 0.f};
#pragma unroll
    for (int hh = 0; hh < 2; ++hh)
#pragma unroll
        for (int mt = 0; mt < NKT; ++mt)
#pragma unroll
            for (int j = 0; j < 4; ++j) { const float e = __builtin_amdgcn_exp2f(fmaxf(acc[hh][mt][j] - mx[hh], -126.f)); acc[hh][mt][j] = e; sum[hh] += e; }
#pragma unroll
    for (int hh = 0; hh < 2; ++hh) { sum[hh] += __shfl_xor(sum[hh], 16); sum[hh] += __shfl_xor(sum[hh], 32); inv_denom[hh] = 1.f / (sum[hh] + __builtin_amdgcn_exp2f(fmaxf(sink2[hh] - mx[hh], -126.f)));
#pragma unroll
        for (int dt = 0; dt < 4; ++dt) o[hh][dt] = (f32x4){0.f, 0.f, 0.f, 0.f}; }
#pragma unroll
    for (int pp = 0; pp < NKT / 2; ++pp) {
        bf16x8 pb[2];
#pragma unroll
        for (int hh = 0; hh < 2; ++hh) { u32x4 pw; pw.x = pk2(acc[hh][2 * pp][0], acc[hh][2 * pp][1]); pw.y = pk2(acc[hh][2 * pp][2], acc[hh][2 * pp][3]); pw.z = pk2(acc[hh][2 * pp + 1][0], acc[hh][2 * pp + 1][1]); pw.w = pk2(acc[hh][2 * pp + 1][2], acc[hh][2 * pp + 1][3]); pb[hh] = __builtin_bit_cast(bf16x8, pw); }
        u32x4 aw[4];
#pragma unroll
        for (int dt = 0; dt < 4; ++dt) { const LAS bf16* vp = Vt + (16 * dt + l16) * VP + 16 * kt0 + 32 * pp + 4 * q4;
            const u32x2 a0 = *(const LAS u32x2*)vp, a1 = *(const LAS u32x2*)(vp + 16);
            aw[dt].x = a0.x; aw[dt].y = a0.y; aw[dt].z = a1.x; aw[dt].w = a1.y; }
        asm volatile("" ::: "memory");
#pragma unroll
        for (int dt = 0; dt < 4; ++dt) { o[0][dt] = mfma16(__builtin_bit_cast(bf16x8, aw[dt]), pb[0], o[0][dt]); o[1][dt] = mfma16(__builtin_bit_cast(bf16x8, aw[dt]), pb[1], o[1][dt]); }
    }
}

__device__ __forceinline__ void swa_prompt_item(KPp p, int l, int item, LAS unsigned char* lds) {
    const int tid = opq_tid(), lane = tid & 63, wave = tid >> 6, l16 = lane & 15, q4 = lane >> 4;
    const int qb = item & 15, kvh = (item >> 4) & 1, b = item >> 5;
    LAS bf16* Ks = (LAS bf16*)lds; LAS bf16* Vt = (LAS bf16*)(lds + 36864);
    const bf16* Z = (const bf16*)(p->ws + WS_Z); bf16* BR1 = (bf16*)(p->ws + WS_BR) + (size_t)MT * 512;
    const float* qnorm = p->in[8] + l * 64; const float* knorm = p->in[9] + l * 64;
    const int tblk = qb * 128;
    const bf16* qrp = Z + ((size_t)b * SEQ + tblk + 16 * wave + l16) * DIN + C_ZQ + kvh * 256 + 8 * q4;
    bf16x8 qc[2][2];
#pragma unroll
    for (int hh = 0; hh < 2; ++hh) { qc[hh][0] = *(const bf16x8*)(qrp + hh * 64); qc[hh][1] = *(const bf16x8*)(qrp + hh * 64 + 32); }
#pragma unroll
    for (int pass = 0; pass < 2; ++pass) {
        const int jj = pass * 128 + (tid >> 2), sq = tid & 3, tok = tblk - 128 + jj;
        if (tok >= 0) {
            const bf16* zr = Z + (size_t)(b * SEQ + tok) * DIN;
            float y1[8], y2[8];
            float ss = unpack8(*(const bf16x8*)(zr + C_ZK + kvh * 64 + 8 * sq), y1) + unpack8(*(const bf16x8*)(zr + C_ZK + kvh * 64 + 32 + 8 * sq), y2);
            ss += __shfl_xor(ss, 1); ss += __shfl_xor(ss, 2);
            norm_rope8(y1, y2, ss, knorm, sq, (float)tok, 1.f);
            *(LAS bf16x8*)(Ks + jj * 72 + 8 * sq) = pack8(y1); *(LAS bf16x8*)(Ks + jj * 72 + 32 + 8 * sq) = pack8(y2);
            const bf16x8 v1 = *(const bf16x8*)(zr + C_ZV + kvh * 64 + 8 * sq), v2 = *(const bf16x8*)(zr + C_ZV + kvh * 64 + 32 + 8 * sq);
#pragma unroll
            for (int e = 0; e < 8; ++e) { Vt[(8 * sq + e) * 264 + jj] = (bf16)v1[e]; Vt[(32 + 8 * sq + e) * 264 + jj] = (bf16)v2[e]; }
            if (qb == 15 && pass == 1) {
                float* ok = p->out + O_CKP + ((size_t)((l * 8 + b) * 128 + (jj - 128)) * 2 + kvh) * 64;
                float* ov = p->out + O_CVP + ((size_t)((l * 8 + b) * 128 + (jj - 128)) * 2 + kvh) * 64;
#pragma unroll
                for (int e = 0; e < 8; ++e) { ok[8 * sq + e] = y1[e]; ok[32 + 8 * sq + e] = y2[e]; ov[8 * sq + e] = bf2f((unsigned short)v1[e]); ov[32 + 8 * sq + e] = bf2f((unsigned short)v2[e]); }
            }
        } else {
            const bf16x8 z8 = {0, 0, 0, 0, 0, 0, 0, 0};
            *(LAS bf16x8*)(Ks + jj * 72 + 8 * sq) = z8; *(LAS bf16x8*)(Ks + jj * 72 + 32 + 8 * sq) = z8;
#pragma unroll
            for (int e = 0; e < 8; ++e) { Vt[(8 * sq + e) * 264 + jj] = 0; Vt[(32 + 8 * sq + e) * 264 + jj] = 0; }
        }
    }
    LBAR();
    {
        const int qi = 16 * wave + l16; const size_t row = (size_t)b * SEQ + tblk + qi;
        float rc[8], rsn[8]; rope_tab8((float)(tblk + qi), q4, rc, rsn);
        const int kt0 = wave < 6 ? wave : 6;
#pragma unroll 1
        for (int g = 0; g < 4; g += 2) {
            bf16x8 qf[2][2]; float sk[2];
#pragma unroll
            for (int hh = 0; hh < 2; ++hh) { float y1[8], y2[8];
                float ss = unpack8(qc[hh][0], y1) + unpack8(qc[hh][1], y2);
                ss += __shfl_xor(ss, 16); ss += __shfl_xor(ss, 32);
                norm_rope8t(y1, y2, ss, qnorm, q4, rc, rsn, 0.125f * LOG2E);
                qf[hh][0] = pack8(y1); qf[hh][1] = pack8(y2); sk[hh] = p->in[10][l * 8 + kvh * 4 + g + hh] * LOG2E; }
            { const int gn = g < 2 ? g + 2 : 2;
#pragma unroll
                for (int hh = 0; hh < 2; ++hh) { qc[hh][0] = *(const bf16x8*)(qrp + (gn + hh) * 64); qc[hh][1] = *(const bf16x8*)(qrp + (gn + hh) * 64 + 32); } }
            f32x4 o[2][4]; float inv[2];
            attn_core2<10, 264>(Ks, Vt, kt0, qf, qi, qi + 128, qb > 0 ? 0 : 128, sk, o, inv);
#pragma unroll
            for (int hh = 0; hh < 2; ++hh)
#pragma unroll
                for (int dt = 0; dt < 4; ++dt) { u32x2 w; w.x = pk2(o[hh][dt][0] * inv[hh], o[hh][dt][1] * inv[hh]); w.y = pk2(o[hh][dt][2] * inv[hh], o[hh][dt][3] * inv[hh]);
                    *(u32x2*)(BR1 + row * 512 + (kvh * 4 + g + hh) * 64 + 16 * dt + 4 * q4) = w; }
        }
    }
    LBAR();
}

__device__ __forceinline__ void swa_sample_item(KPp p, int l, int item, LAS unsigned char* lds) {
    const int tid = opq_tid(), lane = tid & 63, wave = tid >> 6, l16 = lane & 15, q4 = lane >> 4;
    const int kvh = item & 1, b = item >> 1;
    LAS bf16* Ks = (LAS bf16*)lds; LAS bf16* Vt = (LAS bf16*)(lds + 23040);
    const bf16* Z = (const bf16*)(p->ws + WS_Z); bf16* BR1 = (bf16*)(p->ws + WS_BR) + (size_t)MT * 512;
    const float* qnorm = p->in[8] + l * 64; const float* knorm = p->in[9] + l * 64;
    const float* ck = p->in[3] + (size_t)(l * 128 + b) * 128 * 128; const float* cv = p->in[4] + (size_t)(l * 128 + b) * 128 * 128;
    float* ok = p->out + O_CKS + (size_t)(l * 128 + b) * 128 * 128; float* ov = p->out + O_CVS + (size_t)(l * 128 + b) * 128 * 128;
    const bf16* qr_pre = Z + ((size_t)MP + 4 * b + (l16 >> 2)) * DIN + C_ZQ + (kvh * 4 + (l16 & 3)) * 64;
    const bf16x8 qpre0 = *(const bf16x8*)(qr_pre + 8 * q4), qpre1 = *(const bf16x8*)(qr_pre + 32 + 8 * q4);
    for (int i = tid; i < 28 * 64; i += 512) { const int r = 132 + (i >> 6), c = i & 63; Ks[r * 72 + c] = 0; Vt[c * 168 + r] = 0; }
#pragma unroll
    for (int k = 0; k < 4; ++k) { const int idx = tid + 512 * k, j = idx >> 4, c4 = idx & 15;
        const f32x4 kv = *(const f32x4*)(ck + (size_t)j * 128 + kvh * 64 + 4 * c4), vv = *(const f32x4*)(cv + (size_t)j * 128 + kvh * 64 + 4 * c4);
        u32x2 w; w.x = pk2(kv[0], kv[1]); w.y = pk2(kv[2], kv[3]); *(LAS u32x2*)(Ks + j * 72 + 4 * c4) = w;
#pragma unroll
        for (int e = 0; e < 4; ++e) Vt[(4 * c4 + e) * 168 + j] = f2bf(vv[e]);
        if (j >= 4) { *(f32x4*)(ok + (size_t)(j - 4) * 128 + kvh * 64 + 4 * c4) = kv; *(f32x4*)(ov + (size_t)(j - 4) * 128 + kvh * 64 + 4 * c4) = vv; } }
    if (tid < 16) { const int t = tid >> 2, sq = tid & 3; const bf16* zr = Z + (size_t)(MP + 4 * b + t) * DIN;
        float y1[8], y2[8];
        float ss = unpack8(*(const bf16x8*)(zr + C_ZK + kvh * 64 + 8 * sq), y1) + unpack8(*(const bf16x8*)(zr + C_ZK + kvh * 64 + 32 + 8 * sq), y2);
        ss += __shfl_xor(ss, 1); ss += __shfl_xor(ss, 2);
        norm_rope8(y1, y2, ss, knorm, sq, (float)(PAST + t), 1.f);
        *(LAS bf16x8*)(Ks + (128 + t) * 72 + 8 * sq) = pack8(y1); *(LAS bf16x8*)(Ks + (128 + t) * 72 + 32 + 8 * sq) = pack8(y2);
        const bf16x8 v1 = *(const bf16x8*)(zr + C_ZV + kvh * 64 + 8 * sq), v2 = *(const bf16x8*)(zr + C_ZV + kvh * 64 + 32 + 8 * sq);
#pragma unroll
        for (int e = 0; e < 8; ++e) { Vt[(8 * sq + e) * 168 + 128 + t] = (bf16)v1[e]; Vt[(32 + 8 * sq + e) * 168 + 128 + t] = (bf16)v2[e];
            ok[(size_t)(124 + t) * 128 + kvh * 64 + 8 * sq + e] = y1[e]; ok[(size_t)(124 + t) * 128 + kvh * 64 + 32 + 8 * sq + e] = y2[e];
            ov[(size_t)(124 + t) * 128 + kvh * 64 + 8 * sq + e] = bf2f((unsigned short)v1[e]); ov[(size_t)(124 + t) * 128 + kvh * 64 + 32 + 8 * sq + e] = bf2f((unsigned short)v2[e]); }
    }
    LBAR();
    if (wave == 0) {
        const int t = l16 >> 2, g = l16 & 3, h = kvh * 4 + g; const size_t row = (size_t)MP + 4 * b + t;
        float y1[8], y2[8];
        float ss = unpack8(qpre0, y1) + unpack8(qpre1, y2);
        ss += __shfl_xor(ss, 16); ss += __shfl_xor(ss, 32);
        norm_rope8(y1, y2, ss, qnorm, q4, (float)(PAST + t), 0.125f * LOG2E);
        f32x4 o[4]; float inv;
        attn_core<10, 168, false>(Ks, Vt, 0, pack8(y1), pack8(y2), t, 128 + t, 0, p->in[10][l * 8 + h] * LOG2E, o, inv);
#pragma unroll
        for (int dt = 0; dt < 4; ++dt) { u32x2 w; w.x = pk2(o[dt][0] * inv, o[dt][1] * inv); w.y = pk2(o[dt][2] * inv, o[dt][3] * inv);
            *(u32x2*)(BR1 + row * 512 + h * 64 + 16 * dt + 4 * q4) = w; }
    }
    LBAR();
}

__device__ __forceinline__ float hgrn_lower(const float* lbp, int l, int c) {
    const float v0 = lbp[c], v1 = lbp[512 + c], v2 = lbp[1024 + c], v3 = lbp[1536 + c];
    const float m = fmaxf(fmaxf(v0, v1), fmaxf(v2, v3));
    const float e0 = __expf(v0 - m), e1 = __expf(v1 - m), e2 = __expf(v2 - m), e3 = __expf(v3 - m), inv = 1.f / (e0 + e1 + e2 + e3);
    float cum = 0.f; if (l >= 1) cum += e1; if (l >= 2) cum += e2; if (l >= 3) cum += e3;
    return fmaxf(cum * inv, 0.f);
}

struct P1Raw { unsigned short hf[16], hq[16], hi[16]; };
__device__ __forceinline__ void hgrn_p1_load(KPp p, int ci, P1Raw& r) {
    const int tid = opq_tid(), ch = tid & 127, qt = tid >> 7, n = ci & 31, h = (ci >> 5) & 3, b = ci >> 7;
    const bf16* zr = (const bf16*)(p->ws + WS_Z) + ((size_t)b * SEQ + 64 * n + 16 * qt) * DIN + h * 128 + ch;
#pragma unroll
    for (int tt = 0; tt < 16; ++tt) { r.hf[tt] = zr[(size_t)tt * DIN + C_HF]; r.hq[tt] = zr[(size_t)tt * DIN + C_HQ]; r.hi[tt] = zr[(size_t)tt * DIN + C_HI]; }
}
__device__ __forceinline__ void hgrn_p1_item(KPp p, int l, int ci, LAS unsigned char* lds, const P1Raw& raw) {
    const int tid = opq_tid(), lane = tid & 63, wave = tid >> 6, l16 = lane & 15, q4 = lane >> 4;
    const int ch = tid & 127, qt = tid >> 7, n = ci & 31, h = (ci >> 5) & 3, b = ci >> 7;
    LAS bf16* Qm = (LAS bf16*)lds;
    LAS bf16* Km = (LAS bf16*)(lds + 17408);
    LAS bf16* KlT = (LAS bf16*)(lds + 34816);
    LAS bf16* It = (LAS bf16*)(lds + 53248);
    LAS bf16* As = (LAS bf16*)(lds + 71680);
    LAS float* tot = (LAS float*)(lds + 80896);
    const bf16* Z = (const bf16*)(p->ws + WS_Z); bf16* BR0 = (bf16*)(p->ws + WS_BR);
    const float lb = hgrn_lower(p->in[11], l, h * 128 + ch), oml = 1.f - lb, lbf = fmaxf(lb, 1e-30f);
    const size_t R0 = (size_t)b * SEQ + 64 * n;
    float cs[16], kgv[16]; unsigned short hqv[16], hiv[16];
    { float run = 0.f;
#pragma unroll
        for (int tt = 0; tt < 16; ++tt) { const float zf = bf2f(raw.hf[tt]); hqv[tt] = raw.hq[tt]; hiv[tt] = raw.hi[tt];
            const float ez = __expf(-zf), sg = __builtin_amdgcn_rcpf(1.f + ez); run += __logf(lbf + oml * sg); cs[tt] = run; kgv[tt] = oml * ez * sg; }
        tot[qt * 128 + ch] = run; }
    LBAR();
    { const float t0 = tot[ch], t1 = tot[128 + ch], t2 = tot[256 + ch], t3 = tot[384 + ch];
        const float Gm = t0 + t1, Gl = Gm + t2 + t3, pre = (qt == 0) ? 0.f : (qt == 1) ? t0 : (qt == 2) ? Gm : Gm + t2;
        float kl[16];
#pragma unroll
        for (int tt = 0; tt < 16; ++tt) { const float G = pre + cs[tt], hq = bf2f(hqv[tt]), qv = hq * sigm(hq);
            Qm[(16 * qt + tt) * 136 + ch] = f2bf(qv * __expf(G - Gm)); Km[(16 * qt + tt) * 136 + ch] = f2bf(kgv[tt] * __expf(Gm - G)); kl[tt] = kgv[tt] * __expf(Gl - G);
            BR0[(R0 + 16 * qt + tt) * 512 + h * 128 + ch] = f2bf(qv * __expf(G)); }
        u32x4 w0, w1; w0.x = pk2(kl[0], kl[1]); w0.y = pk2(kl[2], kl[3]); w0.z = pk2(kl[4], kl[5]); w0.w = pk2(kl[6], kl[7]);
        w1.x = pk2(kl[8], kl[9]); w1.y = pk2(kl[10], kl[11]); w1.z = pk2(kl[12], kl[13]); w1.w = pk2(kl[14], kl[15]);
        *(LAS u32x4*)(KlT + ch * 72 + 16 * qt) = w0; *(LAS u32x4*)(KlT + ch * 72 + 16 * qt + 8) = w1;
        u32x4 i0, i1;
        i0.x = hiv[0] | ((unsigned)hiv[1] << 16); i0.y = hiv[2] | ((unsigned)hiv[3] << 16); i0.z = hiv[4] | ((unsigned)hiv[5] << 16); i0.w = hiv[6] | ((unsigned)hiv[7] << 16);
        i1.x = hiv[8] | ((unsigned)hiv[9] << 16); i1.y = hiv[10] | ((unsigned)hiv[11] << 16); i1.z = hiv[12] | ((unsigned)hiv[13] << 16); i1.w = hiv[14] | ((unsigned)hiv[15] << 16);
        *(LAS u32x4*)(It + ch * 72 + 16 * qt) = i0; *(LAS u32x4*)(It + ch * 72 + 16 * qt + 8) = i1;
        if (qt == 0) ((float*)(p->ws + WS_DV))[(size_t)ci * 128 + ch] = __expf(Gl); }
    LBAR();
    {
#pragma unroll
        for (int k2 = 0; k2 < 2; ++k2) { const int st = wave & 3, tq = (wave >> 2) * 2 + k2; f32x4 a = (f32x4){0.f, 0.f, 0.f, 0.f};
            if (st <= tq) {
#pragma unroll
                for (int ks = 0; ks < 4; ++ks) a = mfma16(*(const LAS bf16x8*)(Km + (16 * st + l16) * 136 + 32 * ks + 8 * q4), *(const LAS bf16x8*)(Qm + (16 * tq + l16) * 136 + 32 * ks + 8 * q4), a);
                const int t = 16 * tq + l16, s0 = 16 * st + 4 * q4;
#pragma unroll
                for (int r = 0; r < 4; ++r) a[r] = (s0 + r <= t) ? a[r] : 0.f; }
            u32x2 w; w.x = pk2(a[0], a[1]); w.y = pk2(a[2], a[3]); *(LAS u32x2*)(As + (16 * tq + l16) * 72 + 16 * st + 4 * q4) = w; } }
    LBAR();
    {
        const int tq = wave & 3, eh = wave >> 2;
        f32x4 o[4];
#pragma unroll
        for (int et = 0; et < 4; ++et) o[et] = (f32x4){0.f, 0.f, 0.f, 0.f};
#pragma unroll
        for (int ks = 0; ks < 2; ++ks) { const bf16x8 bq = *(const LAS bf16x8*)(As + (16 * tq + l16) * 72 + 32 * ks + 8 * q4);
#pragma unroll
            for (int et = 0; et < 4; ++et) o[et] = mfma16(*(const LAS bf16x8*)(It + (64 * eh + 16 * et + l16) * 72 + 32 * ks + 8 * q4), bq, o[et]); }
        u32x2* oi = (u32x2*)(p->ws + WS_OI) + (size_t)ci * 2048 + (size_t)(wave * 4) * 64 + lane;
#pragma unroll
        for (int et = 0; et < 4; ++et) { u32x2 w; w.x = pk2(o[et][0], o[et][1]); w.y = pk2(o[et][2], o[et][3]); oi[et * 64] = w; } }
    {
        f32x4 L[8];
#pragma unroll
        for (int et = 0; et < 8; ++et) L[et] = (f32x4){0.f, 0.f, 0.f, 0.f};
#pragma unroll
        for (int ks = 0; ks < 2; ++ks) { const bf16x8 a = *(const LAS bf16x8*)(KlT + (16 * wave + l16) * 72 + 32 * ks + 8 * q4);
#pragma unroll
            for (int et = 0; et < 8; ++et) L[et] = mfma16(a, *(const LAS bf16x8*)(It + (16 * et + l16) * 72 + 32 * ks + 8 * q4), L[et]); }
        u32x2* lo = (u32x2*)(p->ws + WS_G) + (size_t)ci * 4096 + (size_t)(wave * 8) * 64 + lane;
#pragma unroll
        for (int et = 0; et < 8; ++et) { u32x2 w; w.x = pk2(L[et][0], L[et][1]); w.y = pk2(L[et][2], L[et][3]); lo[et * 64] = w; } }
    LBAR();
}
__device__ __forceinline__ void hgrn_p2(KPp p, int l, int bh, int tr, int tb) {
    const int tid = opq_tid();
    const u32x2* LST = (const u32x2*)(p->ws + WS_G); u32x2* SST = (u32x2*)(p->ws + WS_G + WS_SST_OFF); const float* DV = (const float*)(p->ws + WS_DV);
#pragma unroll 1
    for (int g4 = tr * 512 + tid; g4 < 4096; g4 += tb * 512) {
        const int w = g4 >> 9, et = (g4 >> 6) & 7, lane = g4 & 63, d0 = 16 * w + 4 * (lane >> 4), e = 16 * et + (lane & 15);
        f32x4 S = (f32x4){0.f, 0.f, 0.f, 0.f};
#pragma unroll 16
        for (int n = 0; n < 32; ++n) { const size_t ci = (size_t)bh * 32 + n;
            u32x2 w2; w2.x = pk2(S[0], S[1]); w2.y = pk2(S[2], S[3]); SST[ci * 4096 + g4] = w2;
            const u32x2 lz = LST[ci * 4096 + g4]; const f32x4 dv = *(const f32x4*)(DV + ci * 128 + d0);
            const f32x4 L = (f32x4){__uint_as_float(lz.x << 16), __uint_as_float(lz.x & 0xffff0000u), __uint_as_float(lz.y << 16), __uint_as_float(lz.y & 0xffff0000u)};
            S = dv * S + L; }
        float* so = p->out + O_SHP + (size_t)(l * 32 + bh) * 16384;
#pragma unroll
        for (int r = 0; r < 4; ++r) so[(size_t)(d0 + r) * 128 + e] = S[r];
    }
}
__device__ __forceinline__ void hgrn_p3_item(KPp p, int l, int ci, LAS unsigned char* lds, bool dry) {
    const int tid = opq_tid(), lane = tid & 63, wave = tid >> 6, l16 = lane & 15, q4 = lane >> 4;
    const int n = ci & 31, h = (ci >> 5) & 3, b = ci >> 7;
    LAS bf16* Qs = (LAS bf16*)lds;
    LAS float* ssp = (LAS float*)(lds + 17408);
    const bf16* Z = (const bf16*)(p->ws + WS_Z); bf16* BR0 = (bf16*)(p->ws + WS_BR);
    const size_t R0 = (size_t)b * SEQ + 64 * n;
#pragma unroll
    for (int k = 0; k < 2; ++k) { const int idx = tid + 512 * k, t = idx >> 4, c8 = idx & 15;
        *(LAS u32x4*)(Qs + t * 136 + 8 * c8) = *(const u32x4*)(BR0 + (R0 + t) * 512 + h * 128 + 8 * c8); }
    const int tq = wave & 3, eh = wave >> 2;
    f32x4 o[4];
    { const u32x2* oi = (const u32x2*)(p->ws + WS_OI) + (size_t)ci * 2048 + (size_t)(wave * 4) * 64 + lane;
#pragma unroll
        for (int et = 0; et < 4; ++et) { const u32x2 w = oi[et * 64]; o[et][0] = __uint_as_float(w.x << 16); o[et][1] = __uint_as_float(w.x & 0xffff0000u); o[et][2] = __uint_as_float(w.y << 16); o[et][3] = __uint_as_float(w.y & 0xffff0000u); } }
    const u32x2* sst = (const u32x2*)(p->ws + WS_G + WS_SST_OFF) + (size_t)ci * 4096 + lane;
    u32x2 sa[4][4][2];
#pragma unroll
    for (int w2 = 0; w2 < 4; ++w2)
#pragma unroll
        for (int et = 0; et < 4; ++et) { sa[w2][et][0] = sst[((2 * w2) * 8 + 4 * eh + et) * 64]; sa[w2][et][1] = sst[((2 * w2 + 1) * 8 + 4 * eh + et) * 64]; }
    u32x2 hzv[4]; f32x4 onv[4];
    { const size_t rowh = R0 + 16 * tq + l16; const float* onorm = p->in[12] + l * 128;
#pragma unroll
        for (int et = 0; et < 4; ++et) { const int e0 = 64 * eh + 16 * et + 4 * q4; hzv[et] = *(const u32x2*)(Z + rowh * DIN + C_HG + h * 128 + e0); onv[et] = *(const f32x4*)(onorm + e0); } }
    LBAR();
#pragma unroll
    for (int w2 = 0; w2 < 4; ++w2) { const LAS bf16* qp = Qs + (16 * tq + l16) * 136 + 32 * w2 + 4 * q4;
        const u32x2 b0 = *(const LAS u32x2*)qp, b1 = *(const LAS u32x2*)(qp + 16);
        u32x4 bw; bw.x = b0.x; bw.y = b0.y; bw.z = b1.x; bw.w = b1.y;
#pragma unroll
        for (int et = 0; et < 4; ++et) { u32x4 aw; aw.x = sa[w2][et][0].x; aw.y = sa[w2][et][0].y; aw.z = sa[w2][et][1].x; aw.w = sa[w2][et][1].y;
            o[et] = mfma16(__builtin_bit_cast(bf16x8, aw), __builtin_bit_cast(bf16x8, bw), o[et]); } }
    { float s = 0.f;
#pragma unroll
        for (int et = 0; et < 4; ++et) s += (o[et][0] * o[et][0] + o[et][1] * o[et][1]) + (o[et][2] * o[et][2] + o[et][3] * o[et][3]);
        s += __shfl_xor(s, 16); s += __shfl_xor(s, 32);
        if (q4 == 0) ssp[eh * 64 + 16 * tq + l16] = s; }
    LBAR();
    { const int t = 16 * tq + l16; const float rstd = rsqrtf((ssp[t] + ssp[64 + t]) * (1.f / 128.f) + 1e-6f); const size_t row = R0 + t;
#pragma unroll
        for (int et = 0; et < 4; ++et) { const int e0 = 64 * eh + 16 * et + 4 * q4;
            const u32x2 hz = hzv[et]; const f32x4 on = onv[et];
            const float g0 = __uint_as_float(hz.x << 16), g1 = __uint_as_float(hz.x & 0xffff0000u), g2 = __uint_as_float(hz.y << 16), g3 = __uint_as_float(hz.y & 0xffff0000u);
            u32x2 w; w.x = pk2(o[et][0] * rstd * on[0] * g0 * sigm(g0), o[et][1] * rstd * on[1] * g1 * sigm(g1)); w.y = pk2(o[et][2] * rstd * on[2] * g2 * sigm(g2), o[et][3] * rstd * on[3] * g3 * sigm(g3));
            if (!dry) *(u32x2*)(BR0 + row * 512 + h * 128 + e0) = w; } }
    LBAR();
}

__device__ __forceinline__ void hgrn_sample_item(KPp p, int l, int item, LAS unsigned char* lds) {
    const int tid = opq_tid(), lane = tid & 63, wave = tid >> 6;
    const int e = tid & 127, dg = tid >> 7, b = item >> 2, h = item & 3;
    LAS float* fv = (LAS float*)lds;
    LAS float* kv = fv + 512;
    LAS float* qv = kv + 512;
    LAS float* iv = qv + 512;
    LAS float* part = iv + 512;
    LAS float* wsum = part + 2048;
    const bf16* Z = (const bf16*)(p->ws + WS_Z); bf16* BR0 = (bf16*)(p->ws + WS_BR);
    const float* S0 = p->in[2] + (size_t)((l * 128 + b) * 4 + h) * 16384;
    float* So = p->out + O_SHS + (size_t)((l * 128 + b) * 4 + h) * 16384;
    float s[32];
#pragma unroll
    for (int k = 0; k < 32; ++k) s[k] = S0[(size_t)(32 * dg + k) * 128 + e];
    const unsigned short hg_raw = Z[((size_t)MP + 4 * b + dg) * DIN + C_HG + h * 128 + e]; const float on_pre = p->in[12][l * 128 + e];
    { const int t = dg, d = e; const float lb = hgrn_lower(p->in[11], l, h * 128 + d), oml = 1.f - lb;
        const bf16* zr = Z + (size_t)(MP + 4 * b + t) * DIN + h * 128 + d;
        const float zf = bf2f(zr[C_HF]), hq = bf2f(zr[C_HQ]), ez = __expf(-zf), sg = __builtin_amdgcn_rcpf(1.f + ez);
        fv[t * 128 + d] = fmaxf(lb, 1e-30f) + oml * sg; kv[t * 128 + d] = oml * ez * sg; qv[t * 128 + d] = hq * sigm(hq); iv[t * 128 + d] = bf2f(zr[C_HI]); }
    LBAR();
#pragma unroll
    for (int t = 0; t < 4; ++t) { const float ii = iv[t * 128 + e]; float po = 0.f;
#pragma unroll
        for (int k = 0; k < 32; ++k) { const int d = 32 * dg + k; s[k] = fv[t * 128 + d] * s[k] + kv[t * 128 + d] * ii; po += s[k] * qv[t * 128 + d]; }
        part[(t * 4 + dg) * 128 + e] = po; }
#pragma unroll
    for (int k = 0; k < 32; ++k) So[(size_t)(32 * dg + k) * 128 + e] = s[k];
    LBAR();
    { const int t = dg; const float o = (part[(t * 4 + 0) * 128 + e] + part[(t * 4 + 1) * 128 + e]) + (part[(t * 4 + 2) * 128 + e] + part[(t * 4 + 3) * 128 + e]);
        float ss = o * o;
#pragma unroll
        for (int k = 1; k < 64; k <<= 1) ss += __shfl_xor(ss, k);
        if (lane == 0) wsum[wave] = ss;
        LBAR();
        const float rstd = rsqrtf((wsum[2 * t] + wsum[2 * t + 1]) * (1.f / 128.f) + 1e-6f);
        const size_t row = (size_t)MP + 4 * b + t; const float hg = bf2f(hg_raw);
        BR0[row * 512 + h * 128 + e] = f2bf(o * rstd * on_pre * hg * sigm(hg)); }
    LBAR();
}

template <int NTT>
__device__ __forceinline__ void pool_mma(KPp p, int l, int g, const LAS bf16* Dl, size_t row_base, int row_stride_unused) {
    const int tid_ = opq_tid(); const int lane = tid_ & 63, wave = tid_ >> 6, l16 = lane & 15, q4 = lane >> 4;
    const bf16* Wp = (const bf16*)(p->ws + WS_WPL) + (size_t)(l * 4 + g) * 16384;
    bf16* BR2 = (bf16*)(p->ws + WS_BR) + (size_t)2 * MT * 512;
    const float* scale = p->in[14] + l * 512 + g * 128;
    for (int tile = wave; tile < NTT * 8; tile += 8) { const int tt = tile % NTT, nt = tile / NTT;
        f32x4 a = (f32x4){0.f, 0.f, 0.f, 0.f};
#pragma unroll
        for (int ks = 0; ks < 4; ++ks) a = mfma16(*(const bf16x8*)(Wp + (size_t)(16 * nt + l16) * 128 + 32 * ks + 8 * q4), *(const LAS bf16x8*)(Dl + (16 * tt + l16) * 136 + 32 * ks + 8 * q4), a);
        const f32x4 sv = *(const f32x4*)(scale + 16 * nt + 4 * q4);
        u32x2 w; w.x = pk2(a[0] * sv[0], a[1] * sv[1]); w.y = pk2(a[2] * sv[2], a[3] * sv[3]);
        *(u32x2*)(BR2 + (row_base + 16 * tt + l16) * 512 + g * 128 + 16 * nt + 4 * q4) = w; }
}
__device__ __forceinline__ void pool_prompt_item(KPp p, int l, int item, LAS unsigned char* lds) {
    const int tid = opq_tid(), lane = tid & 63, wave = tid >> 6, l16 = lane & 15, q4 = lane >> 4;
    const int g = item & 3, tile = item >> 2, b = tile >> 4, t0 = (tile & 15) * 128, w = 2 << g;
    LAS float* U = (LAS float*)lds;
    LAS bf16* Dl = (LAS bf16*)(lds + 73216);
    const bf16* Z = (const bf16*)(p->ws + WS_Z);
    const bf16* Wp = (const bf16*)(p->ws + WS_WPL) + (size_t)(l * 4 + g) * 16384;
    bf16x8 wa[4];
#pragma unroll
    for (int ks = 0; ks < 4; ++ks) wa[ks] = *(const bf16x8*)(Wp + (size_t)(16 * wave + l16) * 128 + 32 * ks + 8 * q4);
    const f32x4 sv = *(const f32x4*)(p->in[14] + l * 512 + g * 128 + 16 * wave + 4 * q4);
#pragma unroll 1
    for (int idx = tid; idx < 143 * 16; idx += 512) { const int r = idx >> 4, c8 = idx & 15, tok = t0 - 15 + r;
        float y[8];
        if (tok >= 0) { unpack8(*(const bf16x8*)(Z + (size_t)(b * SEQ + tok) * DIN + C_U + g * 128 + 8 * c8), y); }
        else {
#pragma unroll
            for (int e = 0; e < 8; ++e) y[e] = 0.f; }
        *(LAS f32x4*)(U + r * 128 + 8 * c8) = (f32x4){y[0], y[1], y[2], y[3]}; *(LAS f32x4*)(U + r * 128 + 8 * c8 + 4) = (f32x4){y[4], y[5], y[6], y[7]}; }
    LBAR();
    { const int c = tid & 127, tq = tid >> 7, tf = 32 * tq;
        float s = 0.f;
        for (int k = 0; k < w; ++k) s += U[(15 + tf - k) * 128 + c];
        const float invw = 1.f / (float)w;
#pragma unroll 4
        for (int t = tf; t < tf + 32; ++t) { const int tok = t0 + t; const float cur = U[(15 + t) * 128 + c];
            const float inv = (tok + 1 >= w) ? invw : 1.f / (float)(tok + 1);
            Dl[t * 136 + c] = f2bf(s * inv - cur);
            const float add = (t < 127) ? U[(16 + t) * 128 + c] : 0.f;
            s += add - U[(16 + t - w) * 128 + c]; }
        if (t0 == SEQ - 128) {
            for (int idx = tid; idx < 15 * 128; idx += 512) { const int r = idx >> 7, cc = idx & 127; p->out[O_SPP + ((size_t)(l * 8 + b) * 15 + r) * 512 + g * 128 + cc] = U[(15 + 113 + r) * 128 + cc]; } } }
    LBAR();
    { bf16* BR2 = (bf16*)(p->ws + WS_BR) + (size_t)2 * MT * 512; const size_t rb = (size_t)b * SEQ + t0;
#pragma unroll
        for (int tt = 0; tt < 8; ++tt) { f32x4 a = (f32x4){0.f, 0.f, 0.f, 0.f};
#pragma unroll
            for (int ks = 0; ks < 4; ++ks) a = mfma16(wa[ks], *(const LAS bf16x8*)(Dl + (16 * tt + l16) * 136 + 32 * ks + 8 * q4), a);
            u32x2 wv; wv.x = pk2(a[0] * sv[0], a[1] * sv[1]); wv.y = pk2(a[2] * sv[2], a[3] * sv[3]);
            *(u32x2*)(BR2 + (rb + 16 * tt + l16) * 512 + g * 128 + 16 * wave + 4 * q4) = wv; } }
    LBAR();
}
__device__ __forceinline__ void pool_sample_item(KPp p, int l, int item, LAS unsigned char* lds) {
    const int tid = opq_tid(); const int g = item & 3, b0 = (item >> 2) * 4, w = 2 << g;
    LAS float* U = (LAS float*)lds;
    LAS bf16* Dl = (LAS bf16*)(lds + 40448);
    const bf16* Z = (const bf16*)(p->ws + WS_Z);
    for (int idx = tid; idx < 4 * 19 * 128; idx += 512) { const int c = idx & 127, r = (idx >> 7) % 19, bb = (idx >> 7) / 19, b = b0 + bb;
        float v;
        if (r < 15) v = p->in[5][((size_t)(l * 128 + b) * 15 + r) * 512 + g * 128 + c];
        else v = bf2f(Z[(size_t)(MP + 4 * b + (r - 15)) * DIN + C_U + g * 128 + c]);
        U[idx] = v;
        if (r >= 4) p->out[O_SPS + ((size_t)(l * 128 + b) * 15 + (r - 4)) * 512 + g * 128 + c] = v; }
    LBAR();
    for (int idx = tid; idx < 16 * 128; idx += 512) { const int c = idx & 127, rt = idx >> 7, bb = rt >> 2, t = rt & 3;
        float s = 0.f; for (int k = 0; k < w; ++k) s += U[(bb * 19 + 15 + t - k) * 128 + c];
        Dl[rt * 136 + c] = f2bf(s / (float)w - U[(bb * 19 + 15 + t) * 128 + c]); }
    LBAR();
    pool_mma<1>(p, l, g, Dl, (size_t)MP + 4 * b0, 0);
    LBAR();
}

#define XB_TMO      128
#define XB_XCNT(j)  (256  + 64 * (j))
#define XB_XSUB(j)  (1280 + 64 * (j))
#define XB_XGEN(j)  (2304 + 64 * (j))
#define XB_TOP      3328
#define XB_TOPGEN   3392
#define XCD_BAR_WORDS 3456
#define XB_SPIN_CAP (1u << 18)

__device__ __forceinline__ unsigned xb_ld(unsigned* p)              { return __hip_atomic_load(p, __ATOMIC_RELAXED, __HIP_MEMORY_SCOPE_AGENT); }
__device__ __forceinline__ unsigned xb_add(unsigned* p, unsigned v) { return __hip_atomic_fetch_add(p, v, __ATOMIC_RELAXED, __HIP_MEMORY_SCOPE_AGENT); }
__device__ __forceinline__ unsigned xb_xcc_id() { return (unsigned)__builtin_amdgcn_s_getreg((3 << 11) | 20) & 0xFu; }
#define XB_SPIN(cond, bar) do { unsigned _sp = 0; while (cond) { __builtin_amdgcn_s_sleep(1); \
    if ((++_sp & 255u) == 0u) { if (xb_ld(&(bar)[XB_TMO])) break; if (_sp > XB_SPIN_CAP) { atomicAdd(&(bar)[XB_TMO], 1u); break; } } } } while (0)

struct XcdBarrier {
    unsigned* bar; unsigned x;
    volatile LAS unsigned* st;
};

__device__ __forceinline__ XcdBarrier xcd_barrier_post(unsigned* bar, volatile LAS unsigned* st) {
    XcdBarrier b; b.bar = bar; b.x = xb_xcc_id(); b.st = st;
    if (threadIdx.x == 0) (void)xb_add(&bar[XB_XCNT(b.x)], 1u);
    return b;
}
__device__ __forceinline__ void xcd_barrier_complete(unsigned* bar, unsigned x, unsigned& nloc, unsigned& nx) {
    const unsigned G = gridDim.x * gridDim.y * gridDim.z;
    unsigned sum, cnt, mine, sp = 0u;
    for (;;) {
        sum = 0u; cnt = 0u; mine = 0u;
#pragma unroll
        for (unsigned j = 0; j < 16; ++j) { const unsigned c = xb_ld(&bar[XB_XCNT(j)]); sum += c; cnt += (c > 0u) ? 1u : 0u; mine = (j == x) ? c : mine; }
        if (sum == G) break;
        __builtin_amdgcn_s_sleep(1);
        if ((++sp & 255u) == 0u) { if (xb_ld(&bar[XB_TMO])) break; if (sp > XB_SPIN_CAP) { atomicAdd(&bar[XB_TMO], 1u); break; } }
    }
    nloc = mine > 0u ? mine : 1u; nx = cnt > 0u ? cnt : 1u;
}

__device__ __forceinline__ void xcd_barrier(const XcdBarrier& b) {
    asm volatile("s_waitcnt vmcnt(0)" ::: "memory");
    __syncthreads();
    if (threadIdx.x == 0) {
        unsigned* bar = b.bar;
        __builtin_amdgcn_s_waitcnt(0);
        unsigned nloc = b.st[0], nx = b.st[1];
        if (nloc == 0u) { xcd_barrier_complete(bar, b.x, nloc, nx); b.st[0] = nloc; b.st[1] = nx; }
        const unsigned old = xb_add(&bar[XB_XSUB(b.x)], 1u);
        const unsigned gen = old / nloc;
        if (old + 1u == (gen + 1u) * nloc) {
            __builtin_amdgcn_fence(__ATOMIC_RELEASE, "agent");
            asm volatile("s_waitcnt vmcnt(0)" ::: "memory");
            const unsigned og = xb_add(&bar[XB_TOP], 1u);
            const unsigned tg = og / nx;
            if (og + 1u == (tg + 1u) * nx) xb_add(&bar[XB_TOPGEN], 1u);
            else XB_SPIN(xb_ld(&bar[XB_TOPGEN]) == tg, bar);
            __builtin_amdgcn_fence(__ATOMIC_ACQUIRE, "agent");
            xb_add(&bar[XB_XGEN(b.x)], 1u);
            asm volatile("s_waitcnt vmcnt(0)" ::: "memory");
        } else {
            XB_SPIN(xb_ld(&bar[XB_XGEN(b.x)]) == gen, bar);
            __builtin_amdgcn_fence(__ATOMIC_ACQUIRE, "agent");
            asm volatile("s_waitcnt vmcnt(0)" ::: "memory");
        }
    }
    __syncthreads();
}

__device__ __forceinline__ f32x4 tail_core(const bf16* A, const bf16* Bt, int K, LAS f32x4* red) {
    const int tid = opq_tid(), lane = tid & 63, wave = tid >> 6, l16 = lane & 15, q4 = lane >> 4;
    const int kper = K >> 3;
    f32x4 acc[2][4];
#pragma unroll
    for (int mt = 0; mt < 2; ++mt)
#pragma unroll
        for (int nt = 0; nt < 4; ++nt) acc[mt][nt] = (f32x4){0.f, 0.f, 0.f, 0.f};
    const bf16* ap = A + (size_t)l16 * K + wave * kper + 16 * q4;
    const bf16* bp = Bt + (size_t)l16 * K + wave * kper + 16 * q4;
#pragma unroll 4
    for (int k = 0; k < kper; k += 64) {
        bf16x8 a[2][2], b[4][2];
#pragma unroll
        for (int mt = 0; mt < 2; ++mt) { a[mt][0] = *(const bf16x8*)(ap + (size_t)mt * 16 * K + k); a[mt][1] = *(const bf16x8*)(ap + (size_t)mt * 16 * K + k + 8); }
#pragma unroll
        for (int nt = 0; nt < 4; ++nt) { b[nt][0] = *(const bf16x8*)(bp + (size_t)nt * 16 * K + k); b[nt][1] = *(const bf16x8*)(bp + (size_t)nt * 16 * K + k + 8); }
#pragma unroll
        for (int h2 = 0; h2 < 2; ++h2)
#pragma unroll
            for (int mt = 0; mt < 2; ++mt)
#pragma unroll
                for (int nt = 0; nt < 4; ++nt) acc[mt][nt] = mfma16(b[nt][h2], a[mt][h2], acc[mt][nt]);
    }
#pragma unroll
    for (int mt = 0; mt < 2; ++mt)
#pragma unroll
        for (int nt = 0; nt < 4; ++nt) red[(wave * 8 + mt * 4 + nt) * 64 + lane] = acc[mt][nt];
    __syncthreads();
    f32x4 sum = red[wave * 64 + lane];
#pragma unroll
    for (int w = 1; w < 8; ++w) sum += red[(w * 8 + wave) * 64 + lane];
    __syncthreads();
    return sum;
}
__device__ __forceinline__ void tail_branch(KPp p, int l, LAS unsigned char* lds) {
#pragma unroll 1
    for (int piece = blockIdx.x; piece < 256; piece += gridDim.x) {
        const int tid = opq_tid(), lane = tid & 63, wave = tid >> 6, l16 = lane & 15, q4 = lane >> 4;
        const int mb = piece >> 4, nb = piece & 15, row = MP + 32 * mb + 16 * (wave >> 2) + l16, c = 64 * nb + 16 * (wave & 3) + 4 * q4;
        const bf16* Z = (const bf16*)(p->ws + WS_Z);
        f32x4 tot = (f32x4){0.f, 0.f, 0.f, 0.f};
#pragma unroll 1
        for (int br = 0; br < 3; ++br) {
            const f32x4 v = tail_core((const bf16*)(p->ws + WS_BR) + ((size_t)br * MT + MP + 32 * mb) * 512, (const bf16*)(p->ws + WS_WBR) + ((size_t)(l * 3 + br) * 1024 + 64 * nb) * 512, 512, (LAS f32x4*)lds);
            const u32x2 gz = *(const u32x2*)(Z + (size_t)row * DIN + C_ZG + br * 1024 + c);
            tot[0] += v[0] * sigm(__uint_as_float(gz.x << 16)); tot[1] += v[1] * sigm(__uint_as_float(gz.x & 0xffff0000u));
            tot[2] += v[2] * sigm(__uint_as_float(gz.y << 16)); tot[3] += v[3] * sigm(__uint_as_float(gz.y & 0xffff0000u)); }
        u32x2 w; w.x = pk2(tot[0], tot[1]); w.y = pk2(tot[2], tot[3]);
        *(u32x2*)((bf16*)(p->ws + WS_G) + (size_t)row * 1024 + c) = w;
    }
}
__device__ __forceinline__ void tail_resid(KPp p, const bf16* A, const bf16* Bt, int K, const bf16* res, bf16* xo, float* Xf, float* rowss, LAS unsigned char* lds) {
#pragma unroll 1
    for (int piece = blockIdx.x; piece < 256; piece += gridDim.x) {
        const int tid = opq_tid(), lane = tid & 63, wave = tid >> 6, l16 = lane & 15, q4 = lane >> 4;
        const int mb = piece >> 4, nb = piece & 15, mt = wave >> 2, nt = wave & 3, row = MP + 32 * mb + 16 * mt + l16, c = 64 * nb + 16 * nt + 4 * q4;
        f32x4 x = tail_core(A + (size_t)(MP + 32 * mb) * K, Bt + (size_t)(64 * nb) * K, K, (LAS f32x4*)lds);
        const u32x2 rz = *(const u32x2*)(res + (size_t)row * 1024 + c);
        x[0] += __uint_as_float(rz.x << 16); x[1] += __uint_as_float(rz.x & 0xffff0000u); x[2] += __uint_as_float(rz.y << 16); x[3] += __uint_as_float(rz.y & 0xffff0000u);
        if (Xf) *(f32x4*)(Xf + (size_t)row * 1024 + c) = x;
        u32x2 w; w.x = pk2(x[0], x[1]); w.y = pk2(x[2], x[3]); *(u32x2*)(xo + (size_t)row * 1024 + c) = w;
        LAS float* part = (LAS float*)lds;
        part[(16 * mt + l16) * 16 + nt * 4 + q4] = (x[0] * x[0] + x[1] * x[1]) + (x[2] * x[2] + x[3] * x[3]);
        __syncthreads();
        if (tid < 32) { float ssum = 0.f;
#pragma unroll
            for (int k = 0; k < 16; ++k) ssum += part[tid * 16 + k];
            rowss[(size_t)(MP + 32 * mb + tid) * 16 + nb] = ssum; }
        __syncthreads();
    }
}

__device__ __forceinline__ void tail_up(KPp p, int l, const float* rowss, LAS unsigned char* lds) {
#pragma unroll 1
    for (int piece = blockIdx.x; piece < 256; piece += gridDim.x) {
        const int tid = opq_tid(), lane = tid & 63, wave = tid >> 6, l16 = lane & 15, q4 = lane >> 4;
        const int mb = piece >> 5, nb = piece & 31;
        const bf16* A = (const bf16*)(p->ws + WS_BR) + (size_t)(MP + 64 * mb) * 1024;
#pragma unroll
        for (int i = 0; i < 16; ++i) { const int idx = tid + 512 * i, r = idx >> 7, c = idx & 127;
            *(LAS u32x4*)(lds + r * 2048 + ((c ^ (r & 15)) << 4)) = *(const u32x4*)(A + (size_t)r * 1024 + 8 * c); }
        LBAR();
        const bf16* bp = (const bf16*)(p->ws + WS_WUP) + ((size_t)l * 4096 + 128 * nb + 16 * wave + l16) * 1024 + 16 * q4;
        f32x4 acc[4];
#pragma unroll
        for (int mt = 0; mt < 4; ++mt) acc[mt] = (f32x4){0.f, 0.f, 0.f, 0.f};
#pragma unroll 8
        for (int kb = 0; kb < 16; ++kb) {
            const bf16x8 b0 = *(const bf16x8*)(bp + 64 * kb), b1 = *(const bf16x8*)(bp + 64 * kb + 8);
#pragma unroll
            for (int mt = 0; mt < 4; ++mt) { acc[mt] = mfma16(b0, *(const LAS bf16x8*)(lds + (16 * mt + l16) * 2048 + (((8 * kb + 2 * q4) ^ l16) << 4)), acc[mt]);
                acc[mt] = mfma16(b1, *(const LAS bf16x8*)(lds + (16 * mt + l16) * 2048 + (((8 * kb + 2 * q4 + 1) ^ l16) << 4)), acc[mt]); } }
        bf16* H = (bf16*)(p->ws + WS_Z);
#pragma unroll
        for (int mt = 0; mt < 4; ++mt) { const size_t row = (size_t)MP + 64 * mb + 16 * mt + l16;
            const f32x4 r0 = *(const f32x4*)(rowss + row * 16), r1 = *(const f32x4*)(rowss + row * 16 + 4), r2 = *(const f32x4*)(rowss + row * 16 + 8), r3 = *(const f32x4*)(rowss + row * 16 + 12);
            const float rsum = (((r0[0] + r0[1]) + (r0[2] + r0[3])) + ((r1[0] + r1[1]) + (r1[2] + r1[3]))) + (((r2[0] + r2[1]) + (r2[2] + r2[3])) + ((r3[0] + r3[1]) + (r3[2] + r3[3])));
            const float rs = rsqrtf(rsum * (1.0f / 1024.0f) + 1e-6f);
            float v[4];
#pragma unroll
            for (int j = 0; j < 4; ++j) { const float a = fmaxf(acc[mt][j] * rs, 0.f); v[j] = a * a; }
            u32x2 w; w.x = pk2(v[0], v[1]); w.y = pk2(v[2], v[3]);
            *(u32x2*)(H + row * 4096 + 128 * nb + 16 * wave + 4 * q4) = w; }
        LBAR();
    }
}

__device__ __forceinline__ void team_barrier(unsigned* cnt, unsigned target) {
    asm volatile("s_waitcnt vmcnt(0)" ::: "memory");
    __syncthreads();
    if (threadIdx.x == 0) {
        __builtin_amdgcn_fence(__ATOMIC_RELEASE, "agent");
        asm volatile("s_waitcnt vmcnt(0)" ::: "memory");
        (void)__hip_atomic_fetch_add(cnt, 1u, __ATOMIC_RELAXED, __HIP_MEMORY_SCOPE_AGENT);
        unsigned sp = 0u;
        while (__hip_atomic_load(cnt, __ATOMIC_RELAXED, __HIP_MEMORY_SCOPE_AGENT) < target) { __builtin_amdgcn_s_sleep(1); if (++sp > (1u << 22)) break; }
        __builtin_amdgcn_fence(__ATOMIC_ACQUIRE, "agent");
        asm volatile("s_waitcnt vmcnt(0)" ::: "memory");
    }
    __syncthreads();
}
__device__ __forceinline__ void mixers(KPp p, int l, LAS unsigned char* lds) {
    const int nb = gridDim.x, bid = blockIdx.x, tb = nb / 32, xq = bid & 7, jq = bid >> 3, team = xq * 4 + jq / tb, tr = jq % tb;
    constexpr int N_SP = 256, N_PP = 512, N_HS = 512, N_SS = 256, N_PS = 128;
    unsigned* tcnt = (unsigned*)(p->ws + WS_CTL + 16384) + team * 64;
    { P1Raw cur; hgrn_p1_load(p, team * 32 + (tr < 32 ? tr : 31), cur);
#pragma unroll 1
        for (int n = tr; n < 32; n += tb) { P1Raw nxt; const int nn = n + tb; hgrn_p1_load(p, team * 32 + (nn < 32 ? nn : 31), nxt); hgrn_p1_item(p, l, team * 32 + n, lds, cur); cur = nxt; } }
#pragma unroll 1
    for (int it = bid; it < N_SP; it += nb) swa_prompt_item(p, l, it, lds);
    team_barrier(tcnt, (unsigned)(tb * (2 * l + 1)));
    hgrn_p2(p, l, team, tr, tb);
#pragma unroll 1
    for (int it = bid; it < N_HS; it += nb) hgrn_sample_item(p, l, it, lds);
#pragma unroll 1
    for (int it = bid; it < N_SS; it += nb) swa_sample_item(p, l, it, lds);
#pragma unroll 1
    for (int it = bid; it < N_PS; it += nb) pool_sample_item(p, l, it, lds);
    team_barrier(tcnt, (unsigned)(tb * (2 * l + 2)));
#pragma unroll 1
    for (int n = tr; n < 32; n += tb) hgrn_p3_item(p, l, team * 32 + n, lds, false);
#pragma unroll 1
    for (int it = bid; it < N_PP; it += nb) pool_prompt_item(p, l, it, lds);
}

constexpr int LDS_BYTES = 147456;
__global__ void __launch_bounds__(512, 2) fwd_mega(KP p_unused) {
    extern __shared__ __attribute__((aligned(16))) unsigned char lds_raw[];
    LAS unsigned char* lds = (LAS unsigned char*)lds_raw;
    cg::grid_group grid = cg::this_grid();
    KPp p = kargs();
    unsigned char* ws = p->ws;
    const int lo = p->ph_lo, hi = p->ph_hi;
    const int G = gridDim.x, cid = blockIdx.x;
    float* rowss = (float*)(ws + WS_RS);
    bf16* Zb = (bf16*)(ws + WS_Z); bf16* XB = (bf16*)(ws + WS_XB); bf16* BRb = (bf16*)(ws + WS_BR); bf16* GBb = (bf16*)(ws + WS_G);
    float* X = p->out + O_Y;
    if (threadIdx.x < 64) ((LAS unsigned*)(lds + 131072))[threadIdx.x] = 0u;
    __syncthreads();
    if (blockIdx.x == 0) { unsigned* ctl = (unsigned*)(ws + WS_CTL);
        for (int i = threadIdx.x; i < 8192; i += 512) __hip_atomic_store(ctl + i, 0u, __ATOMIC_RELAXED, __HIP_MEMORY_SCOPE_AGENT);
        asm volatile("s_waitcnt vmcnt(0)" ::: "memory"); }
    grid.sync();
    XcdBarrier bar = xcd_barrier_post((unsigned*)(ws + WS_CTL), (volatile LAS unsigned*)(lds + 131072) + 8);
#define IN(k) (lo <= (k) && (k) < hi)
#define SEAM(k) do { if (IN(k) && IN((k) + 1)) { for (int r_ = 0; r_ < REP_SYNC; ++r_) { xcd_barrier(bar); } } } while (0)
    if (EN(0) && IN(0)) { for (int r_ = 0; r_ < REP_P0; ++r_) { prologue(kargs(), lds); __syncthreads(); } }
    SEAM(0);
#pragma unroll 1
    for (int l = 0; l < DEPTH; ++l) {
        const int ph = 1 + 6 * l;
        if (EN(1) && IN(ph)) for (int r_ = 0; r_ < REP_A; ++r_) {
            pg8::Gemm g{XB, (const bf16*)(ws + WS_WIN) + (size_t)l * 6400 * 1024, MT, DIN, 1024}; pg8::StaticOrder S; S.init(MT, DIN, G, cid);
            pg8::EpiScaleBf16<0, true> E{Zb, DIN, rowss + (size_t)(2 * l) * MT * 16};
            pg8::gemm_phase<pg8::EpiScaleBf16<0, true>, pg8::StaticOrder, true, true>(lds, g, S, E);
            { const int nun = NMT * (DIN / 256), rem = nun % G;
                if (r_ == 0) { const int b0 = (rem > 0 && rem < G) ? rem : 0;
                    if (cid >= b0) { wconv_layer(kargs(), l, lds, b0, 1); if (l + 1 < DEPTH) wconv_layer(kargs(), l + 1, lds, b0, 0); } } } }
        SEAM(ph);
        if (EN(2) && IN(ph + 1)) { for (int r_ = 0; r_ < REP_B; ++r_) { mixers(kargs(), l, lds); __syncthreads(); } }
        SEAM(ph + 1);
        if (EN(3) && IN(ph + 2)) for (int r_ = 0; r_ < REP_C; ++r_) {
            pg8::Gemm g{BRb, (const bf16*)(ws + WS_WBR) + (size_t)l * 3 * 1024 * 512, 3 * MT, 3 * 1024, 512}; pg8::BranchOrder S; S.init(MP, MT, G, cid);
            pg8::EpiBranch E{Zb, GBb, NMT};
            pg8::gemm_phase<pg8::EpiBranch, pg8::BranchOrder, true, true>(lds, g, S, E);
            tail_branch(kargs(), l, lds); }
        SEAM(ph + 2);
        if (EN(4) && IN(ph + 3)) for (int r_ = 0; r_ < REP_D; ++r_) {
            pg8::Gemm g{GBb, (const bf16*)(ws + WS_WO) + (size_t)l * 1024 * 1024, MP, 1024, 1024}; pg8::StaticOrder S; S.init(MP, 1024, G, cid);
            pg8::EpiResid E{XB, BRb, nullptr, rowss + (size_t)(2 * l + 1) * MT * 16};
            pg8::gemm_phase<pg8::EpiResid, pg8::StaticOrder, true, true>(lds, g, S, E);
            tail_resid(kargs(), GBb, (const bf16*)(ws + WS_WO) + (size_t)l * 1024 * 1024, 1024, XB, BRb, nullptr, rowss + (size_t)(2 * l + 1) * MT * 16, lds); }
        SEAM(ph + 3);
        if (EN(5) && IN(ph + 4)) for (int r_ = 0; r_ < REP_E; ++r_) {
            pg8::Gemm g{BRb, (const bf16*)(ws + WS_WUP) + (size_t)l * 4096 * 1024, MP, DFF, 1024}; pg8::StaticOrder S; S.init(MP, DFF, G, cid);
            pg8::EpiScaleBf16<1> E{Zb, DFF, rowss + (size_t)(2 * l + 1) * MT * 16};
            pg8::gemm_phase<pg8::EpiScaleBf16<1>, pg8::StaticOrder, true, true>(lds, g, S, E);
            for (int r2_ = 0; r2_ < REP_TU; ++r2_) tail_up(kargs(), l, rowss + (size_t)(2 * l + 1) * MT * 16, lds); }
        SEAM(ph + 4);
        if (EN(6) && IN(ph + 5)) for (int r_ = 0; r_ < REP_F; ++r_) {
            float* Xf = (l == DEPTH - 1) ? X : nullptr;
            pg8::Gemm g{Zb, (const bf16*)(ws + WS_WDN) + (size_t)l * 1024 * 4096, MP, 1024, DFF}; pg8::StaticOrder S; S.init(MP, 1024, G, cid);
            pg8::EpiResid E{BRb, XB, Xf, rowss + (size_t)(2 * l + 2) * MT * 16};
            pg8::gemm_phase<pg8::EpiResid, pg8::StaticOrder, true, true>(lds, g, S, E);
            for (int r2_ = 0; r2_ < REP_TF; ++r2_) tail_resid(kargs(), Zb, (const bf16*)(ws + WS_WDN) + (size_t)l * 1024 * 4096, DFF, BRb, XB, Xf, rowss + (size_t)(2 * l + 2) * MT * 16, lds); }
        SEAM(ph + 5);
    }
#undef IN
#undef SEAM
}

#ifndef MK_LAUNCH_MODE
#define MK_LAUNCH_MODE 0
#endif
extern "C" void kernel_launch(void* const* d_in, const int* in_sizes, int n_in, void* d_out, int out_size, void* d_ws, size_t ws_size, hipStream_t stream) {
    static int grid = 0;
    if (grid == 0) {
        if (n_in != 20 || ws_size < WS_END) { fprintf(stderr, "kernel_launch: unexpected n_in %d or ws_size %zu (< %zu)\n", n_in, ws_size, (size_t)WS_END); grid = -1; return; }
        int dev = 0, cus = 0, per_cu = 0;
        hipGetDevice(&dev); hipDeviceGetAttribute(&cus, hipDeviceAttributeMultiprocessorCount, dev);
        hipFuncSetAttribute((const void*)fwd_mega, hipFuncAttributeMaxDynamicSharedMemorySize, LDS_BYTES);
        if (hipOccupancyMaxActiveBlocksPerMultiprocessor(&per_cu, (const void*)fwd_mega, 512, LDS_BYTES) != hipSuccess || per_cu < 1) per_cu = 1;
        (void)hipGetLastError();
        grid = cus * 1;
        if (grid <= 0) grid = 256;
        grid -= grid % 32;
    }
    if (grid < 0) return;
    KP a{};
    for (int i = 0; i < 20; ++i) a.in[i] = (const float*)d_in[i];
    a.out = (float*)d_out; a.ws = (unsigned char*)d_ws;
#if MK_LAUNCH_MODE == 0
    a.ph_lo = 0; a.ph_hi = 25;
    void* args[] = {&a};
    hipError_t e = hipLaunchCooperativeKernel((const void*)fwd_mega, dim3(grid), dim3(512), args, LDS_BYTES, stream);
    if (e != hipSuccess) fprintf(stderr, "cooperative launch failed: %s (grid %d)\n", hipGetErrorString(e), grid);
#else
    for (int ph = 0; ph < 25; ++ph) { a.ph_lo = ph; a.ph_hi = ph + 1; hipLaunchKernelGGL(fwd_mega, dim3(grid), dim3(512), LDS_BYTES, stream, a); }
#endif
}
```
